# Optimizing an MI355X kernel written in HIP

```python
import math
import jax, jax.numpy as jnp
from jax import lax
import numpy as np

D_MODEL = 2048
BATCH = 2
SEQ = 8192
DEPTH = 2

HEAD_DIM = 64
N_Q_HEADS = 16
N_KV_HEADS = 4
GQA_GROUP = N_Q_HEADS // N_KV_HEADS
WINDOW = 128
ATTN_BLOCK = 128
ATTN_WIDTH = N_Q_HEADS * HEAD_DIM

GLA_HEADS = 4
GLA_DV = 256
GLA_DK = 128
GLA_WIDTH = GLA_HEADS * GLA_DV
GLA_GATE_RANK = 16
GLA_TAU = 16.0
GLA_CHUNK = 64

MIX_WIDTH = ATTN_WIDTH + GLA_WIDTH
D_FF = 4 * D_MODEL
EPS = 1e-6

IN_SIZES = (
    ATTN_WIDTH,
    N_KV_HEADS * HEAD_DIM,
    N_KV_HEADS * HEAD_DIM,
    GLA_HEADS * GLA_DK,
    GLA_HEADS * GLA_DK,
    GLA_WIDTH,
    GLA_WIDTH,
    GLA_GATE_RANK,
)
IN_WIDTH = int(sum(IN_SIZES))
SPLIT_POINTS = [int(v) for v in np.cumsum(IN_SIZES)[:-1]]

kernel_name = "hybrid_swa_gla_parallel_heads"


def rmsnorm(x, g):
    xf = x.astype(jnp.float32)
    y = xf * lax.rsqrt(jnp.mean(xf * xf, axis=-1, keepdims=True) + EPS)
    return (y * g.astype(jnp.float32)).astype(x.dtype)


def alibi_slopes(n):
    return jnp.asarray([2.0 ** (-8.0 * (i + 1) / n) for i in range(n)], dtype=jnp.float32)


def sliding_window_attention(q, k, v, sinks):
    B, S = q.shape[0], q.shape[1]
    nb = S // ATTN_BLOCK
    qb = q.reshape(B, nb, ATTN_BLOCK, N_KV_HEADS, GQA_GROUP, HEAD_DIM)

    def band(t):
        tb = t.reshape(B, nb, ATTN_BLOCK, N_KV_HEADS, HEAD_DIM)
        prev = jnp.concatenate([jnp.zeros_like(tb[:, :1]), tb[:, :-1]], axis=1)
        return jnp.concatenate([prev, tb], axis=2)

    kb, vb = band(k), band(v)
    scores = jnp.einsum('bnqhgd,bnkhd->bnhgqk', qb, kb).astype(jnp.float32) * (HEAD_DIM ** -0.5)

    qi = jnp.arange(ATTN_BLOCK)[:, None]
    kj = jnp.arange(2 * ATTN_BLOCK)[None, :]
    dist = qi + ATTN_BLOCK - kj
    blk = jnp.arange(nb)[:, None, None]
    valid = (dist >= 0)[None] & (dist < WINDOW)[None] & ((blk * ATTN_BLOCK - ATTN_BLOCK + kj[None]) >= 0)
    slopes = alibi_slopes(N_Q_HEADS).reshape(N_KV_HEADS, GQA_GROUP)
    alibi = -slopes[:, :, None, None] * dist.astype(jnp.float32)[None, None]
    scores = scores + alibi[None, None]
    scores = jnp.where(valid[None, :, None, None], scores, jnp.float32(-1e30))

    sink = sinks.astype(jnp.float32).reshape(N_KV_HEADS, GQA_GROUP)[None, None, :, :, None]
    m = jnp.maximum(jnp.max(scores, axis=-1), sink)
    p = jnp.exp(scores - m[..., None])
    denom = jnp.sum(p, axis=-1) + jnp.exp(sink - m)
    probs = (p / denom[..., None]).astype(vb.dtype)
    out = jnp.einsum('bnhgqk,bnkhd->bnqhgd', probs, vb)
    return out.reshape(B, S, N_Q_HEADS * HEAD_DIM)


def gla_chunked(q, k, v, log_a):
    B, S, H, dk = q.shape
    dv = v.shape[-1]
    C = GLA_CHUNK
    nc = S // C
    q, k, v, log_a = [t.reshape(B, nc, C, H, t.shape[-1]) for t in (q, k, v, log_a)]
    b = jnp.cumsum(log_a, axis=2)
    b_last = b[:, :, -1:]
    q_in = q * jnp.exp(b)
    k_in = k * jnp.exp(-b)
    k_state = k * jnp.exp(b_last - b)

    causal = jnp.tril(jnp.ones((C, C), dtype=bool))
    att = jnp.einsum('bnthd,bnshd->bnhts', q_in, k_in)
    att = jnp.where(causal, att, 0.0)
    o_intra = jnp.einsum('bnhts,bnshv->bnthv', att, v)

    def step(state, xs):
        qc, kc, vc, decay = xs
        o = jnp.einsum('bthd,bhdv->bthv', qc, state)
        state = state * decay[..., None] + jnp.einsum('bthd,bthv->bhdv', kc, vc)
        return state, o

    xs = (jnp.moveaxis(q_in, 1, 0), jnp.moveaxis(k_state, 1, 0), jnp.moveaxis(v, 1, 0),
          jnp.moveaxis(jnp.exp(b_last[:, :, 0]), 1, 0))
    state0 = jnp.zeros((B, H, dk, dv), jnp.float32)
    _, o_inter = lax.scan(step, state0, xs)
    o = o_intra + jnp.moveaxis(o_inter, 0, 1)
    return o.reshape(B, S, H, dv)


def setup_inputs(seed: int = 0) -> dict:
    key = jax.random.key(seed)
    ks = jax.random.split(key, 16)
    f32 = jnp.float32
    nrm = lambda k, shape, s: jax.random.normal(k, shape, f32) * s
    return {
        "x": nrm(ks[0], (BATCH, SEQ, D_MODEL), 1.0),
        "norm1_g": 1.0 + nrm(ks[1], (DEPTH, D_MODEL), 0.02),
        "w_in": nrm(ks[2], (DEPTH, D_MODEL, IN_WIDTH), D_MODEL ** -0.5),
        "q_norm_g": 1.0 + nrm(ks[3], (DEPTH, HEAD_DIM), 0.02),
        "k_norm_g": 1.0 + nrm(ks[4], (DEPTH, HEAD_DIM), 0.02),
        "attn_sinks": nrm(ks[5], (DEPTH, N_Q_HEADS), 0.5),
        "gla_gate_w": nrm(ks[6], (DEPTH, GLA_GATE_RANK, GLA_HEADS * GLA_DK), GLA_GATE_RANK ** -0.5),
        "gla_gate_b": nrm(ks[7], (DEPTH, GLA_HEADS * GLA_DK), 0.1),
        "gla_norm_g": 1.0 + nrm(ks[8], (DEPTH, GLA_DV), 0.02),
        "w_out": nrm(ks[9], (DEPTH, MIX_WIDTH, D_MODEL), MIX_WIDTH ** -0.5),
        "norm2_g": 1.0 + nrm(ks[10], (DEPTH, D_MODEL), 0.02),
        "w_up": nrm(ks[11], (DEPTH, D_MODEL, D_FF), D_MODEL ** -0.5),
        "w_down": nrm(ks[12], (DEPTH, D_FF, D_MODEL), D_FF ** -0.5),
    }


def reference(x, norm1_g, w_in, q_norm_g, k_norm_g, attn_sinks, gla_gate_w, gla_gate_b,
              gla_norm_g, w_out, norm2_g, w_up, w_down):
    B, S, _ = x.shape
    for l in range(DEPTH):
        h = rmsnorm(x, norm1_g[l])
        proj = h @ w_in[l]
        aq, ak, av, gq, gk, gv, gr, gz = jnp.split(proj, SPLIT_POINTS, axis=-1)

        aq = rmsnorm(aq.reshape(B, S, N_Q_HEADS, HEAD_DIM), q_norm_g[l])
        ak = rmsnorm(ak.reshape(B, S, N_KV_HEADS, HEAD_DIM), k_norm_g[l])
        av = av.reshape(B, S, N_KV_HEADS, HEAD_DIM)
        o_attn = sliding_window_attention(aq, ak, av, attn_sinks[l])

        gq = gq.reshape(B, S, GLA_HEADS, GLA_DK).astype(jnp.float32) * (GLA_DK ** -0.5)
        gk = gk.reshape(B, S, GLA_HEADS, GLA_DK).astype(jnp.float32)
        gv = gv.reshape(B, S, GLA_HEADS, GLA_DV).astype(jnp.float32)
        gate_logit = (gz @ gla_gate_w[l] + gla_gate_b[l]).astype(jnp.float32)
        log_a = (jax.nn.log_sigmoid(gate_logit) / GLA_TAU).reshape(B, S, GLA_HEADS, GLA_DK)
        o_gla = gla_chunked(gq, gk, gv, log_a).astype(x.dtype)
        o_gla = rmsnorm(o_gla, gla_norm_g[l]).reshape(B, S, GLA_WIDTH)
        o_gla = o_gla * jax.nn.silu(gr)

        mix = jnp.concatenate([o_attn, o_gla], axis=-1)
        x = x + mix @ w_out[l]

        h = rmsnorm(x, norm2_g[l])
        u = jnp.square(jax.nn.relu(h @ w_up[l]))
        x = x + u @ w_down[l]
    return x
```

```cpp
#include <hip/hip_runtime.h>
#include <hip/hip_cooperative_groups.h>
#include <cstdio>
#include <cstdint>
namespace cg = cooperative_groups;
namespace pg8 {
#define PG8_LAS __attribute__((address_space(3)))
typedef unsigned short bf16_t;
typedef short bf16x8 __attribute__((ext_vector_type(8)));
typedef float f32x4 __attribute__((ext_vector_type(4)));
typedef unsigned u32x4 __attribute__((ext_vector_type(4)));
constexpr int BM = 256, BK = 64, HALF = 128, HTB = HALF * BK * 2  , STAGE_BYTES = 8 * HTB, NXCD = 8, WGM = 8;

__host__ __device__ __forceinline__ int lds_byte(int r, int c) { const int st = (r >> 4) * 2 + (c >> 5), rr = r & 15, cc = c & 31, ob = rr * 64 + cc * 2; return st * 1024 + (ob ^ (((ob >> 9) & 1) << 5)); }
__host__ __device__ __forceinline__ void stage_rc(int b, int& R, int& C) { const int st = b / 1024, sb = b % 1024, swz = sb ^ (((sb >> 9) & 1) << 5); R = (st >> 1) * 16 + swz / 64; C = (st & 1) * 32 + (swz % 64) / 2; }
__host__ __device__ __forceinline__ int perm32(int rho) { const int n = rho >> 4, i = rho & 15; return 8 * (i >> 2) + 4 * n + (i & 3); }

struct Unit { int pm, pn; };
struct Gemm { const bf16_t* A; const bf16_t* Bt; int M, N, K; };

struct StaticOrder {
    int nM, nN, nwg, G, c;
    __host__ __device__ void init(int M, int N, int G_, int c_) { nM = M / BM; nN = N / BM; nwg = nM * nN; G = G_; c = c_; }
    __host__ __device__ bool next(int i, Unit& u) const {
        const long L = (long)i * G + c; if (L >= nwg) return false;
        int wgid = (int)L; { const int q = nwg / NXCD, r = nwg % NXCD, xcd = wgid % NXCD, off = wgid / NXCD; wgid = (xcd < r ? xcd * (q + 1) : r * (q + 1) + (xcd - r) * q) + off; }
        const int nig = WGM * nN, gid = wgid / nig, fm = gid * WGM, gsz = (nM - fm) < WGM ? (nM - fm) : WGM;
        u.pm = fm + ((wgid % nig) % gsz); u.pn = (wgid % nig) / gsz; return true;
    }
    __device__ __forceinline__ void a_ready(const Unit&) const {}
    __device__ __forceinline__ void done(const Unit&) const {}
};
typedef float f32x2_t __attribute__((ext_vector_type(2))); typedef __bf16 bf16x2_t __attribute__((ext_vector_type(2)));
__device__ __forceinline__ unsigned cvt_pk_bf16(float lo, float hi) { f32x2_t v = {lo, hi}; bf16x2_t b = __builtin_convertvector(v, bf16x2_t); return __builtin_bit_cast(unsigned, b); }
template <int ACT  > struct EpiBf16 {
    static constexpr bool PERM = true, AFTER_DRAIN = false;
    bf16_t* O; int ldc; const float* SSQ;
    __device__ __forceinline__ void operator()(const f32x4 (&acc)[2][2][4][2], const Unit& u, int wr, int wc, int fr, int fq) const {
        const int row0 = u.pm * BM + wr * 64 + fr; const int col0 = u.pn * BM + wc * 32 + 8 * fq;
        float rsv[2][4];
#pragma unroll
        for (int ai = 0; ai < 2; ++ai)
#pragma unroll
            for (int m = 0; m < 4; ++m) rsv[ai][m] = SSQ[row0 + ai * HALF + m * 16];
#pragma unroll
        for (int ai = 0; ai < 2; ++ai)
#pragma unroll
            for (int m = 0; m < 4; ++m) { const int row = row0 + ai * HALF + m * 16; bf16_t* rowp = O + (size_t)row * ldc + col0;
                const float rs = rsqrtf(rsv[ai][m] * (1.0f / 2048.0f) + 1e-6f);
#pragma unroll
                for (int bj = 0; bj < 2; ++bj) { f32x4 v0 = acc[ai][bj][m][0] * rs, v1 = acc[ai][bj][m][1] * rs;
                    if (ACT == 2) { const f32x4 z = {0.f, 0.f, 0.f, 0.f}; v0 = __builtin_elementwise_max(v0, z); v1 = __builtin_elementwise_max(v1, z); v0 = v0 * v0; v1 = v1 * v1; }
                    u32x4 w; w.x = cvt_pk_bf16(v0[0], v0[1]); w.y = cvt_pk_bf16(v0[2], v0[3]); w.z = cvt_pk_bf16(v1[0], v1[1]); w.w = cvt_pk_bf16(v1[2], v1[3]);
                    *(u32x4*)(rowp + bj * HALF) = w; } }
    }
};
template <bool NORM> struct EpiRes {
    static constexpr bool PERM = true, AFTER_DRAIN = false;
    const float* base; float* out; int ldc; const float* g; bf16_t* XG; float* SSQ;
    __device__ __forceinline__ void operator()(const f32x4 (&acc)[2][2][4][2], const Unit& u, int wr, int wc, int fr, int fq) const {
        const int col0 = u.pn * BM + wc * 32 + 8 * fq;
        f32x4 gv[2][2];
        if (NORM) {
#pragma unroll
            for (int bj = 0; bj < 2; ++bj)
#pragma unroll
                for (int n = 0; n < 2; ++n) gv[bj][n] = *(const f32x4*)(g + col0 + bj * HALF + 4 * n); }
#pragma unroll
        for (int ai = 0; ai < 2; ++ai)
#pragma unroll
        for (int mh = 0; mh < 2; ++mh) {
            f32x4 bs[2][2][2];
#pragma unroll
            for (int m2 = 0; m2 < 2; ++m2) { const size_t off = (size_t)(u.pm * BM + ai * HALF + wr * 64 + (2 * mh + m2) * 16 + fr) * ldc + col0;
#pragma unroll
                for (int bj = 0; bj < 2; ++bj)
#pragma unroll
                    for (int n = 0; n < 2; ++n) bs[m2][bj][n] = *(const f32x4*)(base + off + bj * HALF + 4 * n); }
#pragma unroll
            for (int m2 = 0; m2 < 2; ++m2) { const int m = 2 * mh + m2; const int row = u.pm * BM + ai * HALF + wr * 64 + m * 16 + fr; const size_t off = (size_t)row * ldc + col0;
                float ss = 0.f;
#pragma unroll
                for (int bj = 0; bj < 2; ++bj) { const f32x4 v0 = bs[m2][bj][0] + acc[ai][bj][m][0], v1 = bs[m2][bj][1] + acc[ai][bj][m][1];
                    *(f32x4*)(out + off + bj * HALF) = v0; *(f32x4*)(out + off + bj * HALF + 4) = v1;
                    if (NORM) { ss += (v0[0] * v0[0] + v0[1] * v0[1]) + (v0[2] * v0[2] + v0[3] * v0[3]) + (v1[0] * v1[0] + v1[1] * v1[1]) + (v1[2] * v1[2] + v1[3] * v1[3]);
                        const f32x4 y0 = v0 * gv[bj][0], y1 = v1 * gv[bj][1];
                        u32x4 w; w.x = cvt_pk_bf16(y0[0], y0[1]); w.y = cvt_pk_bf16(y0[2], y0[3]); w.z = cvt_pk_bf16(y1[0], y1[1]); w.w = cvt_pk_bf16(y1[2], y1[3]);
                        *(u32x4*)(XG + off + bj * HALF) = w; } }
                if (NORM) { ss += __shfl_xor(ss, 16); ss += __shfl_xor(ss, 32); if (fq == 0) unsafeAtomicAdd(SSQ + row, ss); } }
            asm volatile("" ::: "memory"); }
    }
};
template <class Epi, class Sched, bool ALIGN_EPI = false, bool SP2 = false, bool KSERP = false  >
__device__ __forceinline__ void gemm_phase(PG8_LAS unsigned char* lds, const Gemm g, const Sched& S, const Epi& E) {
    int tid_ = threadIdx.x; asm volatile("" : "+v"(tid_));
    const int tid = tid_, wid = __builtin_amdgcn_readfirstlane(tid >> 6), lane = tid & 63, wr = wid >> 2, wc = wid & 3, fr = lane & 15, fq = lane >> 4;
    const int K = g.K, nt = K / BK;
    unsigned voffA[2], voffB[2];
#pragma unroll
    for (int i = 0; i < 2; ++i) { int R, C; stage_rc(tid * 16 + i * 8192, R, C); const int Rb = Epi::PERM ? ((R & ~31) + perm32(R & 31)) : R;
        voffA[i] = (unsigned)(R * K + C) * 2u; voffB[i] = (unsigned)(Rb * K + C) * 2u; }
    const size_t kstep = (size_t)(BK * 2);
    long ks = (long)kstep, nks = (long)kstep;
    const size_t hstep = (size_t)HALF * K * 2;
    const size_t tstep = 2 * hstep;
    const unsigned ldsw = (unsigned)wid * 1024u;
    const int aoff = lds_byte(wr * 64 + fr, fq * 8), boff = lds_byte(wc * 32 + fr, fq * 8);
#define PG8_SA(b, h) (((b) * 2 + (h)) * HTB)
#define PG8_SB(b, h) ((4 + (b) * 2 + (h)) * HTB)
#define PG8_STAGE(bufoff, gbase, voff) do { _Pragma("unroll") for (int _i = 0; _i < 2; ++_i) \
        __builtin_amdgcn_global_load_lds((const unsigned*)((const char*)(gbase) + (voff)[_i]), (PG8_LAS unsigned*)(lds + (bufoff) + ldsw + _i * 8192), 16, 0, 0); } while (0)
#define PG8_LDA(dst, b, h) do { _Pragma("unroll") for (int m = 0; m < 4; ++m) _Pragma("unroll") for (int k = 0; k < 2; ++k) dst[m][k] = *(const PG8_LAS bf16x8*)(lds + PG8_SA(b, h) + aoff + m * 2048 + k * 1024); } while (0)
#define PG8_LDB(dst, b, h) do { _Pragma("unroll") for (int n = 0; n < 2; ++n) _Pragma("unroll") for (int k = 0; k < 2; ++k) dst[n][k] = *(const PG8_LAS bf16x8*)(lds + PG8_SB(b, h) + boff + n * 2048 + k * 1024); } while (0)
#define PG8_MMA(ai, bj, At, Bt) do { __builtin_amdgcn_s_setprio(1); _Pragma("unroll") for (int m = 0; m < 4; ++m) _Pragma("unroll") for (int n = 0; n < 2; ++n) _Pragma("unroll") for (int k = 0; k < 2; ++k) \
        acc[ai][bj][m][n] = __builtin_amdgcn_mfma_f32_16x16x32_bf16(Bt[n][k], At[m][k], acc[ai][bj][m][n], 0, 0, 0); __builtin_amdgcn_s_setprio(0); } while (0)
#define PG8_WAIT_V(n) asm volatile("s_waitcnt vmcnt(" #n ")" ::: "memory")
#define PG8_WAIT_L(n) asm volatile("s_waitcnt lgkmcnt(" #n ")" ::: "memory")
#define PG8_BAR __builtin_amdgcn_s_barrier()
#define PG8_SCHED __builtin_amdgcn_sched_barrier(0)
    Unit cur, nxt; int ui = 0;
    if (!S.next(0, cur)) return;
    f32x4 acc[2][2][4][2];
#pragma unroll
    for (int a = 0; a < 2; ++a)
#pragma unroll
        for (int b = 0; b < 2; ++b)
#pragma unroll
            for (int m = 0; m < 4; ++m)
#pragma unroll
                for (int n = 0; n < 2; ++n) acc[a][b][m][n] = (f32x4){0.f, 0.f, 0.f, 0.f};
    bf16x8 At[4][2], B0[2][2], B1[2][2];
    const char* cA = (const char*)g.A + (size_t)cur.pm * tstep; const char* cB = (const char*)g.Bt + (size_t)cur.pn * tstep;
    S.a_ready(cur);
    if constexpr (SP2) {
        PG8_STAGE(PG8_SB(0, 0), cB, voffB); PG8_STAGE(PG8_SB(0, 1), cB + hstep, voffB); PG8_STAGE(PG8_SA(0, 0), cA, voffA); PG8_STAGE(PG8_SA(0, 1), cA + hstep, voffA);
        if (wr == 1) PG8_BAR;
        PG8_WAIT_V(2); PG8_BAR;
        PG8_STAGE(PG8_SB(1, 0), cB + ks, voffB); PG8_STAGE(PG8_SA(1, 0), cA + ks, voffA); PG8_STAGE(PG8_SB(1, 1), cB + hstep + ks, voffB);
        PG8_WAIT_V(6); PG8_BAR;
    } else {
        PG8_STAGE(PG8_SB(0, 0), cB, voffB); PG8_STAGE(PG8_SA(0, 0), cA, voffA); PG8_STAGE(PG8_SB(0, 1), cB + hstep, voffB); PG8_STAGE(PG8_SA(0, 1), cA + hstep, voffA);
        if (wr == 1) PG8_BAR;
        PG8_WAIT_V(4); PG8_BAR;
        PG8_STAGE(PG8_SB(1, 0), cB + ks, voffB); PG8_STAGE(PG8_SA(1, 0), cA + ks, voffA); PG8_STAGE(PG8_SB(1, 1), cB + hstep + ks, voffB);
        PG8_WAIT_V(6); PG8_BAR;
    }
    for (;;) {
        const bool has_next = S.next(ui + 1, nxt);
        const bool nrev = KSERP && has_next && (((ui + 1) & 1) != 0); const size_t noff = nrev ? (size_t)(nt - 1) * kstep : 0;
        const char* nA = has_next ? (const char*)g.A + (size_t)nxt.pm * tstep + noff : cA; const char* nB = has_next ? (const char*)g.Bt + (size_t)nxt.pn * tstep + noff : cB;
        nks = has_next ? (nrev ? -(long)kstep : (long)kstep) : ks;
        for (int t = 0; t < nt; t += 2) {
            const bool last = (t == nt - 2);
            const char* a1 = cA + (long)(t + 1) * ks;
            const char* a2 = last ? nA : cA + (long)(t + 2) * ks; const char* b2 = last ? nB : cB + (long)(t + 2) * ks;
            const char* a3 = a2 + (last ? nks : ks); const char* b3 = b2 + (last ? nks : ks);
            if (last && has_next) S.a_ready(nxt);
            if constexpr (SP2) {
            PG8_LDB(B0, 0, 0); PG8_LDB(B1, 0, 1); PG8_SCHED; PG8_LDA(At, 0, 0); PG8_STAGE(PG8_SA(1, 1), a1 + hstep, voffA);
            PG8_WAIT_V(8); PG8_WAIT_L(0); PG8_BAR; PG8_MMA(0, 0, At, B0); PG8_MMA(0, 1, At, B1); PG8_BAR; PG8_SCHED;
            PG8_LDA(At, 0, 1); PG8_STAGE(PG8_SB(0, 0), b2, voffB); PG8_STAGE(PG8_SB(0, 1), b2 + hstep, voffB); PG8_STAGE(PG8_SA(0, 0), a2, voffA);
            PG8_WAIT_V(8); PG8_WAIT_L(0); PG8_BAR; PG8_MMA(1, 0, At, B0); PG8_MMA(1, 1, At, B1); PG8_BAR; PG8_SCHED;
            PG8_LDB(B0, 1, 0); PG8_LDB(B1, 1, 1); PG8_SCHED; PG8_LDA(At, 1, 0); PG8_STAGE(PG8_SA(0, 1), a2 + hstep, voffA);
            PG8_WAIT_V(8); PG8_WAIT_L(0); PG8_BAR; PG8_MMA(0, 0, At, B0); PG8_MMA(0, 1, At, B1); PG8_BAR; PG8_SCHED;
            PG8_LDA(At, 1, 1); PG8_STAGE(PG8_SB(1, 0), b3, voffB); PG8_STAGE(PG8_SB(1, 1), b3 + hstep, voffB); PG8_STAGE(PG8_SA(1, 0), a3, voffA);
            PG8_WAIT_V(8); PG8_WAIT_L(0); PG8_BAR; PG8_MMA(1, 0, At, B0); PG8_MMA(1, 1, At, B1); PG8_BAR; PG8_SCHED;
            } else {
            PG8_LDB(B0, 0, 0); PG8_SCHED; PG8_LDA(At, 0, 0); PG8_STAGE(PG8_SA(1, 1), a1 + hstep, voffA);
            PG8_WAIT_L(8); PG8_BAR; PG8_WAIT_L(0); PG8_MMA(0, 0, At, B0); PG8_BAR; PG8_SCHED;
            PG8_LDB(B1, 0, 1); PG8_STAGE(PG8_SB(0, 0), b2, voffB);
            PG8_BAR; PG8_WAIT_L(0); PG8_MMA(0, 1, At, B1); PG8_BAR;
            PG8_LDA(At, 0, 1); PG8_STAGE(PG8_SA(0, 0), a2, voffA);
            PG8_BAR; PG8_WAIT_L(0); PG8_MMA(1, 0, At, B0); PG8_BAR; PG8_SCHED;
            PG8_STAGE(PG8_SB(0, 1), b2 + hstep, voffB);
            PG8_WAIT_V(6); PG8_BAR; PG8_MMA(1, 1, At, B1); PG8_BAR;
            PG8_LDB(B0, 1, 0); PG8_SCHED; PG8_LDA(At, 1, 0); PG8_STAGE(PG8_SA(0, 1), a2 + hstep, voffA);
            PG8_WAIT_L(8); PG8_BAR; PG8_WAIT_L(0); PG8_MMA(0, 0, At, B0); PG8_BAR; PG8_SCHED;
            PG8_LDB(B1, 1, 1); PG8_STAGE(PG8_SB(1, 0), b3, voffB);
            PG8_BAR; PG8_WAIT_L(0); PG8_MMA(0, 1, At, B1); PG8_BAR;
            PG8_LDA(At, 1, 1); PG8_STAGE(PG8_SA(1, 0), a3, voffA);
            PG8_BAR; PG8_WAIT_L(0); PG8_MMA(1, 0, At, B0); PG8_BAR; PG8_SCHED;
            PG8_STAGE(PG8_SB(1, 1), b3 + hstep, voffB);
            PG8_WAIT_V(6); PG8_BAR; PG8_MMA(1, 1, At, B1); PG8_BAR;
            }
        }
        if constexpr (ALIGN_EPI) { if (wr == 0) PG8_BAR; }
        if constexpr (!Epi::AFTER_DRAIN) { E(acc, cur, wr, wc, fr, fq); S.done(cur); }
        if (!has_next) break;
#pragma unroll
        for (int a = 0; a < 2; ++a)
#pragma unroll
            for (int b = 0; b < 2; ++b)
#pragma unroll
                for (int m = 0; m < 4; ++m)
#pragma unroll
                    for (int n = 0; n < 2; ++n) acc[a][b][m][n] = (f32x4){0.f, 0.f, 0.f, 0.f};
        cur = nxt; cA = nA; cB = nB; ks = nks; ++ui;
        if constexpr (ALIGN_EPI) { if (wr == 1) PG8_BAR; }
    }
    PG8_WAIT_V(0);
    if constexpr (!ALIGN_EPI) { if (wr == 0) PG8_BAR; }
    PG8_BAR;
    if constexpr (Epi::AFTER_DRAIN) { E.fused(acc, cur, wr, wc, fr, fq, lds, wid, lane); S.done(cur); }
#undef PG8_SA
#undef PG8_SB
#undef PG8_STAGE
#undef PG8_LDA
#undef PG8_LDB
#undef PG8_MMA
#undef PG8_WAIT_V
#undef PG8_WAIT_L
#undef PG8_BAR
#undef PG8_SCHED
}
}
constexpr int SEQ = 8192, DM = 2048, M = 16384, DEPTH = 2, INW = 4624, LDP = 4864, DFF = 8192;
constexpr int C_AQ = 0, C_AK = 1024, C_AV = 1280, C_GQ = 1536, C_GK = 2048, C_GV = 2560, C_GR = 3584, C_GZ = 4608;
constexpr float EPS = 1e-6f;
constexpr int NWAVES = 8, NT = 512;
constexpr size_t MiB = 1u << 20;
constexpr size_t WS_WIN = 1 * MiB, WS_WOUT = 20 * MiB, WS_WUP = 28 * MiB, WS_WDN = 60 * MiB, WS_XN = 92 * MiB;
constexpr size_t WS_U = 156 * MiB, WS_PROJ = 156 * MiB, WS_MIX = 308 * MiB, WS_KVS = 412 * MiB, WS_DEC = 476 * MiB, WS_END = 477 * MiB;
static_assert(WS_PROJ + (size_t)M * LDP * 2 <= WS_MIX && WS_MIX + (size_t)M * DM * 2 <= WS_KVS && WS_U + (size_t)M * DFF * 2 <= WS_KVS, "ws map");
constexpr int LDS_BYTES = 147456;

#define LAS __attribute__((address_space(3)))
typedef unsigned short bf16;
typedef float f32x4 __attribute__((ext_vector_type(4)));
typedef float f32x16 __attribute__((ext_vector_type(16)));
typedef short bf16x8 __attribute__((ext_vector_type(8)));
typedef unsigned u32x4 __attribute__((ext_vector_type(4)));
typedef unsigned u32x2 __attribute__((ext_vector_type(2)));
#define MFMA32(a, b, c) __builtin_amdgcn_mfma_f32_32x32x16_bf16((a), (b), (c), 0, 0, 0)

__device__ __forceinline__ float bflo(unsigned u) { return __uint_as_float(u << 16); }
__device__ __forceinline__ float bfhi(unsigned u) { return __uint_as_float(u & 0xffff0000u); }
__device__ __forceinline__ unsigned pk(float lo, float hi) { return pg8::cvt_pk_bf16(lo, hi); }
__device__ __forceinline__ float wave_sum(float v) {
#pragma unroll
    for (int o = 1; o < 64; o <<= 1) v += __shfl_xor(v, o);
    return v;
}

__device__ __forceinline__ void transpose_item(const float* W, int K, int Nsrc, int Npad, bf16* WT, LAS float* scr, int item, int lane) {
    const int nblk = Npad / 128, kb = item / nblk, nb = item % nblk, k0 = 32 * kb, n0 = 128 * nb;
    const int nl = (lane & 31) * 4, kr = lane >> 5; const bool ok = (n0 + nl) < Nsrc;
    f32x4 v[16];
#pragma unroll
    for (int i = 0; i < 16; ++i) v[i] = ok ? __builtin_nontemporal_load((const f32x4*)(W + (size_t)(k0 + 2 * i + kr) * Nsrc + n0 + nl)) : (f32x4){0.f, 0.f, 0.f, 0.f};
#pragma unroll
    for (int i = 0; i < 16; ++i) { LAS float* s = scr + (2 * i + kr) * 129 + nl; s[0] = v[i].x; s[1] = v[i].y; s[2] = v[i].z; s[3] = v[i].w; }
    asm volatile("s_waitcnt lgkmcnt(0)" ::: "memory");
    const int nn = lane >> 2, kq = lane & 3;
#pragma unroll
    for (int j = 0; j < 8; ++j) { const int n = j * 16 + nn; const LAS float* s = scr + (kq * 8) * 129 + n;
        u32x4 o; o.x = pk(s[0 * 129], s[1 * 129]); o.y = pk(s[2 * 129], s[3 * 129]); o.z = pk(s[4 * 129], s[5 * 129]); o.w = pk(s[6 * 129], s[7 * 129]);
        *(u32x4*)(WT + (size_t)(n0 + n) * K + k0 + kq * 8) = o; }
    asm volatile("s_waitcnt lgkmcnt(0)" ::: "memory");
}
__device__ __forceinline__ void prep_row(const float* xrow, const float* g, bf16* orow, float* ssq, int lane) {
    const f32x4* xr = (const f32x4*)xrow + lane; f32x4 v[8]; float s = 0.f;
#pragma unroll
    for (int j = 0; j < 8; ++j) { v[j] = __builtin_nontemporal_load(xr + 64 * j); s += (v[j].x * v[j].x + v[j].y * v[j].y) + (v[j].z * v[j].z + v[j].w * v[j].w); }
    s = wave_sum(s); if (lane == 0) *ssq = s;
    u32x2* o8 = (u32x2*)orow + lane; const f32x4* gr = (const f32x4*)g + lane;
#pragma unroll
    for (int j = 0; j < 8; ++j) { const f32x4 gg = gr[64 * j]; u32x2 w; w.x = pk(v[j].x * gg.x, v[j].y * gg.y); w.y = pk(v[j].z * gg.z, v[j].w * gg.w); o8[64 * j] = w; }
}

constexpr int CONV_NQ = 2304;
struct ConvJob { const float* W; bf16* WT; int K, N; };
__device__ __forceinline__ bool conv_decode(int q, const float* w_out, const float* w_up, const float* w_dn, bf16* WoutT, bf16* WupT, bf16* WdnT, ConvJob& j, int& k0, int& n0) {
    if (q >= CONV_NQ) return false;
    if (q < 256) { j.W = w_out; j.WT = WoutT; j.K = DM; j.N = DM; k0 = (q >> 3) * 64; n0 = (q & 7) * 256; }
    else if (q < 1280) { const int r = q - 256; j.W = w_up; j.WT = WupT; j.K = DM; j.N = DFF; k0 = (r >> 5) * 64; n0 = (r & 31) * 256; }
    else { const int r = q - 1280; j.W = w_dn; j.WT = WdnT; j.K = DFF; j.N = DM; k0 = (r >> 3) * 64; n0 = (r & 7) * 256; }
    return true;
}
struct ConvCtx { const float* w_out; const float* w_up; const float* w_dn; bf16* WoutT; bf16* WupT; bf16* WdnT; };
__device__ __forceinline__ void conv_load(const ConvCtx& cx, int q, int tid, f32x4 (&v)[8]) {
    ConvJob j; int k0, n0;
    if (!conv_decode(q, cx.w_out, cx.w_up, cx.w_dn, cx.WoutT, cx.WupT, cx.WdnT, j, k0, n0)) return;
    const float* p = j.W + (size_t)(k0 + (tid >> 6) * 8) * j.N + n0 + (tid & 63) * 4;
#pragma unroll
    for (int r = 0; r < 8; ++r) v[r] = __builtin_nontemporal_load((const f32x4*)(p + (size_t)r * j.N));
}
__device__ __forceinline__ void conv_store(const ConvCtx& cx, int q, int tid, const f32x4 (&v)[8]) {
    ConvJob j; int k0, n0;
    if (!conv_decode(q, cx.w_out, cx.w_up, cx.w_dn, cx.WoutT, cx.WupT, cx.WdnT, j, k0, n0)) return;
    bf16* p = j.WT + (size_t)(n0 + (tid & 63) * 4) * j.K + k0 + (tid >> 6) * 8;
#pragma unroll
    for (int i = 0; i < 4; ++i) { u32x4 o; o.x = pk(v[0][i], v[1][i]); o.y = pk(v[2][i], v[3][i]); o.z = pk(v[4][i], v[5][i]); o.w = pk(v[6][i], v[7][i]); *(u32x4*)(p + (size_t)i * j.K) = o; }
}

__device__ __forceinline__ void attn_item(LAS unsigned char* lds, int item, const bf16* PROJ, bf16* MIX, const float* qng, const float* kng, const float* sinks, const ConvCtx& cx, int cq, int tid, int lane, int wid) {
    const int kvh = item & 3, blk = (item >> 2) & 63, b = item >> 8;
    f32x4 cv[8];
    LAS unsigned char* Ks = lds; LAS unsigned short* Vt = (LAS unsigned short*)(lds + 36864);
    const size_t tok0 = (size_t)b * SEQ + (size_t)blk * 128;
    const int g = wid >> 1, rh = wid & 1, qh = kvh * 4 + g, h = lane >> 5, c = lane & 31;
    u32x4 qq[2][4];
    { const bf16* qp = PROJ + (tok0 + rh * 64 + c) * LDP + C_AQ + qh * 64 + h * 8;
#pragma unroll
        for (int kk = 0; kk < 4; ++kk) qq[0][kk] = *(const u32x4*)(qp + 16 * kk); }
    {
        const int key = tid >> 1, hf = tid & 1; const bool ok = (blk > 0) || (key >= 128);
        u32x4 kq[4], vq[4];
        if (ok) { const bf16* p = PROJ + (tok0 + key - 128) * LDP + C_AK + kvh * 64 + hf * 32;
#pragma unroll
            for (int i = 0; i < 4; ++i) { kq[i] = *(const u32x4*)(p + 8 * i); vq[i] = *(const u32x4*)(p + 256 + 8 * i); } }
        else {
#pragma unroll
            for (int i = 0; i < 4; ++i) { kq[i] = (u32x4){0u, 0u, 0u, 0u}; vq[i] = (u32x4){0u, 0u, 0u, 0u}; } }
        conv_load(cx, cq, tid, cv);
        float kf[32]; float ss = 0.f;
#pragma unroll
        for (int i = 0; i < 4; ++i)
#pragma unroll
            for (int c = 0; c < 4; ++c) { kf[i * 8 + 2 * c] = bflo(kq[i][c]); kf[i * 8 + 2 * c + 1] = bfhi(kq[i][c]); }
#pragma unroll
        for (int i = 0; i < 32; ++i) ss += kf[i] * kf[i];
        ss += __shfl_xor(ss, 1);
        const float rstd = rsqrtf(ss * (1.f / 64.f) + EPS);
#pragma unroll
        for (int i = 0; i < 4; ++i) { u32x4 w;
#pragma unroll
            for (int c = 0; c < 4; ++c) { const int d = hf * 32 + i * 8 + 2 * c; w[c] = pk(kf[i * 8 + 2 * c] * rstd * kng[d], kf[i * 8 + 2 * c + 1] * rstd * kng[d + 1]); }
            *(LAS u32x4*)(Ks + key * 144 + hf * 64 + i * 16) = w; }
#pragma unroll
        for (int i = 0; i < 4; ++i)
#pragma unroll
            for (int c = 0; c < 4; ++c) { const int d = hf * 32 + i * 8 + 2 * c; Vt[d * 260 + key] = (unsigned short)(vq[i][c] & 0xffffu); Vt[(d + 1) * 260 + key] = (unsigned short)(vq[i][c] >> 16); }
    }
    __syncthreads();
    conv_store(cx, cq, tid, cv);
    { const bf16* qp = PROJ + (tok0 + rh * 64 + 32 + c) * LDP + C_AQ + qh * 64 + h * 8;
#pragma unroll
        for (int kk = 0; kk < 4; ++kk) qq[1][kk] = *(const u32x4*)(qp + 16 * kk); }
    const float L2E = 1.4426950408889634f;
    const float slope2 = exp2f(-0.5f * (float)(qh + 1)) * L2E, sink2 = sinks[qh] * L2E;
    const int cm = c - 4 * h;
    const float base = -slope2 * (float)cm;
#pragma unroll 1
    for (int sb = 0; sb < 2; ++sb) {
        const int i0 = rh * 64 + sb * 32, qi = i0 + c;
        float qf[32]; float ss = 0.f;
#pragma unroll
        for (int kk = 0; kk < 4; ++kk)
#pragma unroll
            for (int cc = 0; cc < 4; ++cc) { const unsigned qw = sb ? qq[1][kk][cc] : qq[0][kk][cc]; qf[kk * 8 + 2 * cc] = bflo(qw); qf[kk * 8 + 2 * cc + 1] = bfhi(qw); }
#pragma unroll
        for (int i = 0; i < 32; ++i) ss += qf[i] * qf[i];
        ss += __shfl_xor(ss, 32);
        const float rstd = rsqrtf(ss * (1.f / 64.f) + EPS) * (0.125f * L2E);
        bf16x8 qb[4];
#pragma unroll
        for (int kk = 0; kk < 4; ++kk) { u32x4 w;
#pragma unroll
            for (int cc = 0; cc < 4; ++cc) { const int d = h * 8 + 16 * kk + 2 * cc; w[cc] = pk(qf[kk * 8 + 2 * cc] * rstd * qng[d], qf[kk * 8 + 2 * cc + 1] * rstd * qng[d + 1]); }
            qb[kk] = __builtin_bit_cast(bf16x8, w); }
        f32x16 s[5];
#pragma unroll
        for (int T = 0; T < 5; ++T) {
#pragma unroll
            for (int r = 0; r < 16; ++r) s[T][r] = 0.f;
#pragma unroll
            for (int kk = 0; kk < 4; ++kk) { const bf16x8 a = *(const LAS bf16x8*)(Ks + (i0 + 32 * T + c) * 144 + (h * 8 + 16 * kk) * 2); s[T] = MFMA32(a, qb[kk], s[T]); }
        }
        float mx = -1e30f;
#pragma unroll
        for (int T = 0; T < 5; ++T) {
            const bool dead = (blk == 0) && (i0 + 32 * T < 128);
#pragma unroll
            for (int r = 0; r < 16; ++r) { const int ep = 8 * (r >> 2) + (r & 3); float x = __builtin_fmaf(slope2, (float)(32 * T + ep - 128), s[T][r]);
                if (T == 0) x = (ep > cm) ? x : -1e30f;
                if (T == 4) x = (ep <= cm) ? x : -1e30f;
                if (dead) x = -1e30f;
                s[T][r] = x; mx = fmaxf(mx, x); } }
        float mrow = mx + base; mrow = fmaxf(mrow, __shfl_xor(mrow, 32)); mrow = fmaxf(mrow, sink2);
        const float mp = mrow - base;
        float sum = 0.f;
#pragma unroll
        for (int T = 0; T < 5; ++T)
#pragma unroll
            for (int r = 0; r < 16; ++r) { const float p = __builtin_amdgcn_exp2f(s[T][r] - mp); s[T][r] = p; sum += p; }
        sum += __shfl_xor(sum, 32); sum += __builtin_amdgcn_exp2f(sink2 - mrow);
        const float inv = 1.f / sum;
        f32x16 o[2];
#pragma unroll
        for (int mt = 0; mt < 2; ++mt)
#pragma unroll
            for (int r = 0; r < 16; ++r) o[mt][r] = 0.f;
#pragma unroll
        for (int T = 0; T < 5; ++T)
#pragma unroll
            for (int u = 0; u < 2; ++u) { u32x4 w;
#pragma unroll
                for (int cc = 0; cc < 4; ++cc) w[cc] = pk(s[T][8 * u + 2 * cc], s[T][8 * u + 2 * cc + 1]);
                const bf16x8 pb = __builtin_bit_cast(bf16x8, w);
#pragma unroll
                for (int mt = 0; mt < 2; ++mt) { const LAS unsigned short* vp = Vt + (mt * 32 + c) * 260 + i0 + 32 * T + 16 * u + 4 * h;
                    const u32x2 lo = *(const LAS u32x2*)vp, hi = *(const LAS u32x2*)(vp + 8);
                    const u32x4 av = {lo.x, lo.y, hi.x, hi.y}; o[mt] = MFMA32(__builtin_bit_cast(bf16x8, av), pb, o[mt]); } }
        bf16* op = MIX + (tok0 + qi) * DM + qh * 64 + 4 * h;
#pragma unroll
        for (int mt = 0; mt < 2; ++mt)
#pragma unroll
            for (int q4 = 0; q4 < 4; ++q4) { u32x2 w; w.x = pk(o[mt][4 * q4] * inv, o[mt][4 * q4 + 1] * inv); w.y = pk(o[mt][4 * q4 + 2] * inv, o[mt][4 * q4 + 3] * inv); *(u32x2*)(op + mt * 32 + 8 * q4) = w; }
    }
    __syncthreads();
}

constexpr int GL_GZS = 33792, GL_SEG = 37888, GL_QI = 39936, GL_KI = 58368, GL_AT = 75776, GL_VT = 84992;
__device__ __forceinline__ void gla_gate(LAS unsigned char* lds, unsigned gzw, const float (&w)[16], float bias, int tid) {
    LAS float* BsT = (LAS float*)lds; LAS float* gzs = (LAS float*)(lds + GL_GZS); LAS float* seg = (LAS float*)(lds + GL_SEG);
    { const int t = tid >> 3, r2 = (tid & 7) * 2; gzs[t * 16 + r2] = bflo(gzw); gzs[t * 16 + r2 + 1] = bfhi(gzw); }
    const int j = tid & 127, tq = tid >> 7;
    __syncthreads();
    float val[16]; float run = 0.f;
#pragma unroll
    for (int i = 0; i < 16; ++i) { const LAS f32x4* zp = (const LAS f32x4*)(gzs + (tq * 16 + i) * 16); float z = bias;
#pragma unroll
        for (int v = 0; v < 4; ++v) { const f32x4 zz = zp[v]; z += zz.x * w[4 * v] + zz.y * w[4 * v + 1] + zz.z * w[4 * v + 2] + zz.w * w[4 * v + 3]; }
        const float ls = fminf(z, 0.f) - __logf(1.f + __expf(-fabsf(z))); run += ls * (1.f / 16.f); val[i] = run; }
    seg[tq * 128 + j] = run;
    __syncthreads();
    float off = 0.f;
#pragma unroll
    for (int q = 0; q < 3; ++q) if (q < tq) off += seg[q * 128 + j];
#pragma unroll
    for (int i = 0; i < 16; ++i) BsT[j * 65 + tq * 16 + i] = val[i] + off;
    __syncthreads();
}
__device__ __forceinline__ void gla_scatter_vt(LAS unsigned char* lds, const u32x4 (&vq)[4], int tid) {
    LAS unsigned short* VT = (LAS unsigned short*)(lds + GL_VT); const int t = tid & 63, cw = tid >> 6;
#pragma unroll
    for (int i = 0; i < 4; ++i)
#pragma unroll
        for (int e = 0; e < 4; ++e) { const int c = 8 * (cw + 8 * i) + 2 * e; VT[c * 72 + t] = (unsigned short)(vq[i][e] & 0xffffu); VT[(c + 1) * 72 + t] = (unsigned short)(vq[i][e] >> 16); }
}
constexpr int GL_KST = 121856;
__device__ __forceinline__ void gla_stage_kst(LAS unsigned char* lds, LAS unsigned short* KsT, const u32x4 (&kq)[2], int tid) {
    LAS float* BsT = (LAS float*)lds; LAS float* decs = (LAS float*)(lds + GL_SEG); const int t = tid & 63, cw = tid >> 6;
#pragma unroll
    for (int i = 0; i < 2; ++i)
#pragma unroll
        for (int e = 0; e < 4; ++e) { const int j = 8 * (cw + 8 * i) + 2 * e;
            const float e0 = __expf(BsT[j * 65 + 63] - BsT[j * 65 + t]), e1 = __expf(BsT[(j + 1) * 65 + 63] - BsT[(j + 1) * 65 + t]);
            const unsigned w = pk(bflo(kq[i][e]) * e0, bfhi(kq[i][e]) * e1);
            KsT[j * 72 + t] = (unsigned short)(w & 0xffffu); KsT[(j + 1) * 72 + t] = (unsigned short)(w >> 16); }
    if (tid < 128) decs[tid] = __expf(BsT[tid * 65 + 63]);
}
__device__ __forceinline__ void gla_state_update(LAS unsigned char* lds, const LAS unsigned short* KsT, const bf16x8 (&bv)[4], f32x16 (&S)[4], bool first, int h, int c) {
    const LAS float* decs = (const LAS float*)(lds + GL_SEG);
#pragma unroll
    for (int mt = 0; mt < 4; ++mt) { f32x16 acc;
#pragma unroll
        for (int r = 0; r < 16; ++r) acc[r] = 0.f;
#pragma unroll
        for (int ks = 0; ks < 4; ++ks) { const bf16x8 a = *(const LAS bf16x8*)(KsT + (mt * 32 + c) * 72 + h * 8 + 16 * ks); acc = MFMA32(a, bv[ks], acc); }
        if (first) S[mt] = acc;
        else {
#pragma unroll
            for (int q = 0; q < 4; ++q) { const f32x4 d = *(const LAS f32x4*)(decs + mt * 32 + 8 * q + 4 * h);
#pragma unroll
                for (int e = 0; e < 4; ++e) S[mt][4 * q + e] = S[mt][4 * q + e] * d[e] + acc[4 * q + e]; } }
        __builtin_amdgcn_sched_barrier(0); }
}
__device__ __forceinline__ void gla_local_group(LAS unsigned char* lds, int g, const bf16* PROJ, bf16* KVS, float* DEC, const float (&gwr)[16], float gbias, const ConvCtx& cx, int cq0, int tid, int lane, int wid) {
    const int hh = g & 3, gi = (g >> 2) & 31, b = g >> 7; const int t = tid & 63, cw = tid >> 6, h = lane >> 5, c = lane & 31;
    LAS float* BsT = (LAS float*)lds; LAS unsigned short* KsT = (LAS unsigned short*)(lds + GL_QI); LAS unsigned short* VT = (LAS unsigned short*)(lds + GL_VT);
    f32x16 S[4]; float blsum = 0.f;
#pragma unroll 1
    for (int j = 0; j < 4; ++j) {
        const size_t R0 = (size_t)b * SEQ + (size_t)(gi * 4 + j) * 64; const int cq = cq0 + 2 * (j * 256);
        f32x4 cv[8];
        const unsigned gzw = *(const unsigned*)(PROJ + (R0 + (tid >> 3)) * LDP + C_GZ + (tid & 7) * 2);
        u32x4 kq[2], vq[4];
        { const bf16* rp = PROJ + (R0 + t) * LDP;
#pragma unroll
            for (int i = 0; i < 2; ++i) kq[i] = *(const u32x4*)(rp + C_GK + hh * 128 + 8 * (cw + 8 * i));
#pragma unroll
            for (int i = 0; i < 4; ++i) vq[i] = *(const u32x4*)(rp + C_GV + hh * 256 + 8 * (cw + 8 * i)); }
        conv_load(cx, cq, tid, cv);
        gla_gate(lds, gzw, gwr, gbias, tid);
        conv_store(cx, cq, tid, cv);
        conv_load(cx, cq + 1, tid, cv);
        gla_scatter_vt(lds, vq, tid);
        gla_stage_kst(lds, KsT, kq, tid);
        if (tid < 128) blsum += BsT[tid * 65 + 63];
        __syncthreads();
        { bf16x8 bv[4];
#pragma unroll
            for (int ks = 0; ks < 4; ++ks) bv[ks] = *(const LAS bf16x8*)(VT + (wid * 32 + c) * 72 + h * 8 + 16 * ks);
            gla_state_update(lds, KsT, bv, S, j == 0, h, c); }
        conv_store(cx, cq + 1, tid, cv);
        __syncthreads();
    }
    { bf16* outp = KVS + (size_t)((b * 4 + hh) * 32 + gi) * 32768 + (size_t)(wid * 32 + c) * 128 + 4 * h;
#pragma unroll
        for (int mt = 0; mt < 4; ++mt)
#pragma unroll
            for (int q = 0; q < 4; ++q) { u32x2 w; w.x = pk(S[mt][4 * q], S[mt][4 * q + 1]); w.y = pk(S[mt][4 * q + 2], S[mt][4 * q + 3]); *(u32x2*)(outp + mt * 32 + 8 * q) = w; }
        if (tid < 128) DEC[(size_t)((b * 4 + hh) * 32 + gi) * 128 + tid] = __expf(blsum); }
}
__device__ __forceinline__ void gla_out_group(LAS unsigned char* lds, int g, const bf16* PROJ, const bf16* KVS, bf16* MIX, const float* ggw, const float* ggb, const float* gng, int tid_in, int lane_in, int wid) {
    const int hh = g & 3, gi = (g >> 2) & 31, b = g >> 7;
    LAS float* BsT = (LAS float*)lds; LAS unsigned short* Qi = (LAS unsigned short*)(lds + GL_QI); LAS unsigned short* Ki = (LAS unsigned short*)(lds + GL_KI);
    LAS unsigned short* At = (LAS unsigned short*)(lds + GL_AT); LAS unsigned short* VT = (LAS unsigned short*)(lds + GL_VT); LAS float* Ob = (LAS float*)lds;
    LAS unsigned short* KsT = (LAS unsigned short*)(lds + GL_KST);
    f32x16 S[4];
    { const int h = lane_in >> 5, c = lane_in & 31; const bf16* sp = KVS + (size_t)((b * 4 + hh) * 32 + gi) * 32768 + (size_t)(wid * 32 + c) * 128 + 4 * h;
#pragma unroll
        for (int mt = 0; mt < 4; ++mt)
#pragma unroll
            for (int q = 0; q < 4; ++q) { const u32x2 u = *(const u32x2*)(sp + mt * 32 + 8 * q); S[mt][4 * q] = bflo(u.x); S[mt][4 * q + 1] = bfhi(u.x); S[mt][4 * q + 2] = bflo(u.y); S[mt][4 * q + 3] = bfhi(u.y); } }
#pragma unroll 1
    for (int j = 0; j < 4; ++j) {
        int tid = tid_in; asm volatile("" : "+v"(tid));
        const int lane = tid & 63, t = tid & 63, cw = tid >> 6, h = lane >> 5, c = lane & 31;
        const size_t R0 = (size_t)b * SEQ + (size_t)(gi * 4 + j) * 64;
        const unsigned gzw = *(const unsigned*)(PROJ + (R0 + (tid >> 3)) * LDP + C_GZ + (tid & 7) * 2);
        u32x4 qq[2], kq[2], vq[4]; u32x2 grv[8];
        { const bf16* rp = PROJ + (R0 + t) * LDP;
#pragma unroll
            for (int i = 0; i < 2; ++i) { qq[i] = *(const u32x4*)(rp + C_GQ + hh * 128 + 8 * (cw + 8 * i)); kq[i] = *(const u32x4*)(rp + C_GK + hh * 128 + 8 * (cw + 8 * i)); }
#pragma unroll
            for (int i = 0; i < 4; ++i) vq[i] = *(const u32x4*)(rp + C_GV + hh * 256 + 8 * (cw + 8 * i));
        }
        { float gwr[16];
#pragma unroll
            for (int r = 0; r < 16; ++r) gwr[r] = ggw[r * 512 + hh * 128 + (tid & 127)];
            gla_gate(lds, gzw, gwr, ggb[hh * 128 + (tid & 127)], tid); }
        gla_scatter_vt(lds, vq, tid);
        gla_stage_kst(lds, KsT, kq, tid);
        { const float QS = 0.08838834764831845f;
#pragma unroll
            for (int i = 0; i < 2; ++i) { const int j8 = 8 * (cw + 8 * i); u32x4 oq, ok;
#pragma unroll
                for (int e = 0; e < 4; ++e) { const float b0 = BsT[(j8 + 2 * e) * 65 + t], b1 = BsT[(j8 + 2 * e + 1) * 65 + t];
                    oq[e] = pk(bflo(qq[i][e]) * QS * __expf(b0), bfhi(qq[i][e]) * QS * __expf(b1)); ok[e] = pk(bflo(kq[i][e]) * __expf(-b0), bfhi(kq[i][e]) * __expf(-b1)); }
                *(LAS u32x4*)(Qi + t * 136 + j8) = oq; *(LAS u32x4*)(Ki + t * 136 + j8) = ok; } }
        __syncthreads();
        if (wid < 4) { const int mt = wid >> 1, nt = wid & 1; f32x16 acc;
#pragma unroll
            for (int r = 0; r < 16; ++r) acc[r] = 0.f;
#pragma unroll
            for (int ks = 0; ks < 8; ++ks) { const bf16x8 a = *(const LAS bf16x8*)(Qi + (mt * 32 + c) * 136 + h * 8 + 16 * ks), bb = *(const LAS bf16x8*)(Ki + (nt * 32 + c) * 136 + h * 8 + 16 * ks); acc = MFMA32(a, bb, acc); }
#pragma unroll
            for (int r = 0; r < 16; ++r) { const int tt = mt * 32 + 8 * (r >> 2) + 4 * h + (r & 3), ss = nt * 32 + c; At[tt * 72 + ss] = (unsigned short)((ss <= tt) ? (pk(acc[r], 0.f) & 0xffffu) : 0u); } }
        __syncthreads();
        f32x16 o[2]; bf16x8 bv[4];
#pragma unroll
        for (int mt = 0; mt < 2; ++mt)
#pragma unroll
            for (int r = 0; r < 16; ++r) o[mt][r] = 0.f;
#pragma unroll
        for (int ks = 0; ks < 4; ++ks) { bv[ks] = *(const LAS bf16x8*)(VT + (wid * 32 + c) * 72 + h * 8 + 16 * ks);
#pragma unroll
            for (int mt = 0; mt < 2; ++mt) { const bf16x8 a = *(const LAS bf16x8*)(At + (mt * 32 + c) * 72 + h * 8 + 16 * ks); o[mt] = MFMA32(a, bv[ks], o[mt]); } }
#pragma unroll
        for (int ms = 0; ms < 4; ++ms)
#pragma unroll
            for (int u = 0; u < 2; ++u) { u32x4 w;
#pragma unroll
                for (int e = 0; e < 4; ++e) w[e] = pk(S[ms][8 * u + 2 * e], S[ms][8 * u + 2 * e + 1]);
                const bf16x8 sb = __builtin_bit_cast(bf16x8, w);
#pragma unroll
                for (int mt = 0; mt < 2; ++mt) { const LAS unsigned short* qp = Qi + (mt * 32 + c) * 136 + 32 * ms + 16 * u + 4 * h;
                    const u32x2 lo = *(const LAS u32x2*)qp, hi = *(const LAS u32x2*)(qp + 8); const u32x4 av = {lo.x, lo.y, hi.x, hi.y};
                    o[mt] = MFMA32(__builtin_bit_cast(bf16x8, av), sb, o[mt]); }
                __builtin_amdgcn_sched_barrier(0); }
#pragma unroll
        for (int i = 0; i < 8; ++i) grv[i] = *(const u32x2*)(PROJ + (R0 + wid * 8 + i) * LDP + C_GR + hh * 256 + lane * 4);
        gla_state_update(lds, KsT, bv, S, false, h, c);
        __syncthreads();
#pragma unroll
        for (int mt = 0; mt < 2; ++mt)
#pragma unroll
            for (int r = 0; r < 16; ++r) Ob[(mt * 32 + 8 * (r >> 2) + 4 * h + (r & 3)) * 260 + wid * 32 + c] = o[mt][r];
        __syncthreads();
        const f32x4 g4 = *(const f32x4*)(gng + lane * 4);
#pragma unroll
        for (int i = 0; i < 8; ++i) { const int tt = wid * 8 + i; const f32x4 x = *(const LAS f32x4*)(Ob + tt * 260 + lane * 4);
            const float ss = wave_sum((x.x * x.x + x.y * x.y) + (x.z * x.z + x.w * x.w)); const float rstd = rsqrtf(ss * (1.f / 256.f) + EPS);
            const float r0 = bflo(grv[i].x), r1 = bfhi(grv[i].x), r2 = bflo(grv[i].y), r3 = bfhi(grv[i].y);
            u32x2 w; w.x = pk(x.x * rstd * g4.x * (r0 / (1.f + __expf(-r0))), x.y * rstd * g4.y * (r1 / (1.f + __expf(-r1))));
            w.y = pk(x.z * rstd * g4.z * (r2 / (1.f + __expf(-r2))), x.w * rstd * g4.w * (r3 / (1.f + __expf(-r3))));
            *(u32x2*)(MIX + (R0 + tt) * DM + 1024 + hh * 256 + lane * 4) = w; }
        __syncthreads();
    }
}
#define XB_TMO      128
#define XB_XCNT(j)  (256  + 64 * (j))
#define XB_XSUB(j)  (1280 + 64 * (j))
#define XB_XGEN(j)  (2304 + 64 * (j))
#define XB_TOP      3328
#define XB_TOPGEN   3392
#define XCD_BAR_WORDS 3456
#define XB_SPIN_CAP (1u << 18)

__device__ __forceinline__ unsigned xb_ld(unsigned* p)              { return __hip_atomic_load(p, __ATOMIC_RELAXED, __HIP_MEMORY_SCOPE_AGENT); }
__device__ __forceinline__ unsigned xb_add(unsigned* p, unsigned v) { return __hip_atomic_fetch_add(p, v, __ATOMIC_RELAXED, __HIP_MEMORY_SCOPE_AGENT); }
__device__ __forceinline__ unsigned xb_xcc_id() { return (unsigned)__builtin_amdgcn_s_getreg((3 << 11) | 20) & 0xFu; }
#define XB_SPIN(cond, bar) do { unsigned _sp = 0; while (cond) { __builtin_amdgcn_s_sleep(1); \
    if ((++_sp & 255u) == 0u) { if (xb_ld(&(bar)[XB_TMO])) break; if (_sp > XB_SPIN_CAP) { atomicAdd(&(bar)[XB_TMO], 1u); break; } } } } while (0)

struct XcdBarrier {
    unsigned* bar; unsigned x;
    volatile LAS unsigned* st;
};

__device__ __forceinline__ XcdBarrier xcd_barrier_post(unsigned* bar, volatile LAS unsigned* st) {
    XcdBarrier b; b.bar = bar; b.x = xb_xcc_id(); b.st = st;
    if (threadIdx.x == 0) (void)xb_add(&bar[XB_XCNT(b.x)], 1u);
    return b;
}
__device__ __forceinline__ void xcd_barrier_complete(unsigned* bar, unsigned x, unsigned& nloc, unsigned& nx) {
    const unsigned G = gridDim.x * gridDim.y * gridDim.z;
    unsigned sum, cnt, mine, sp = 0u;
    for (;;) {
        sum = 0u; cnt = 0u; mine = 0u;
#pragma unroll
        for (unsigned j = 0; j < 16; ++j) { const unsigned c = xb_ld(&bar[XB_XCNT(j)]); sum += c; cnt += (c > 0u) ? 1u : 0u; mine = (j == x) ? c : mine; }
        if (sum == G) break;
        __builtin_amdgcn_s_sleep(1);
        if ((++sp & 255u) == 0u) { if (xb_ld(&bar[XB_TMO])) break; if (sp > XB_SPIN_CAP) { atomicAdd(&bar[XB_TMO], 1u); break; } }
    }
    nloc = mine > 0u ? mine : 1u; nx = cnt > 0u ? cnt : 1u;
}

__device__ __forceinline__ void xcd_barrier(const XcdBarrier& b) {
    asm volatile("s_waitcnt vmcnt(0)" ::: "memory");
    __syncthreads();
    if (threadIdx.x == 0) {
        unsigned* bar = b.bar;
        __builtin_amdgcn_s_waitcnt(0);
        unsigned nloc = b.st[0], nx = b.st[1];
        if (nloc == 0u) { xcd_barrier_complete(bar, b.x, nloc, nx); b.st[0] = nloc; b.st[1] = nx; }
        const unsigned old = xb_add(&bar[XB_XSUB(b.x)], 1u);
        const unsigned gen = old / nloc;
        if (old + 1u == (gen + 1u) * nloc) {
            __builtin_amdgcn_fence(__ATOMIC_RELEASE, "agent");
            asm volatile("s_waitcnt vmcnt(0)" ::: "memory");
            const unsigned og = xb_add(&bar[XB_TOP], 1u);
            const unsigned tg = og / nx;
            if (og + 1u == (tg + 1u) * nx) xb_add(&bar[XB_TOPGEN], 1u);
            else XB_SPIN(xb_ld(&bar[XB_TOPGEN]) == tg, bar);
            __builtin_amdgcn_fence(__ATOMIC_ACQUIRE, "agent");
            xb_add(&bar[XB_XGEN(b.x)], 1u);
            asm volatile("s_waitcnt vmcnt(0)" ::: "memory");
        } else {
            XB_SPIN(xb_ld(&bar[XB_XGEN(b.x)]) == gen, bar);
            __builtin_amdgcn_fence(__ATOMIC_ACQUIRE, "agent");
            asm volatile("s_waitcnt vmcnt(0)" ::: "memory");
        }
    }
    __syncthreads();
}
constexpr size_t WS_BAR = 512 * 1024;
constexpr int MISC_OFF = LDS_BYTES - 64;
struct Args { const float* in[13]; float* out; unsigned char* ws; };
__global__ void __launch_bounds__(NT, 2) hybrid_fwd(Args args) {
    extern __shared__ __attribute__((aligned(16))) unsigned char lds_raw[];
    cg::grid_group grid = cg::this_grid();
    LAS unsigned char* lds = (LAS unsigned char*)lds_raw;
    const int tid0 = threadIdx.x, wid = __builtin_amdgcn_readfirstlane(tid0 >> 6);
    const int G = gridDim.x, bx = blockIdx.x;
    const int gw = bx * NWAVES + wid, NGW = G * NWAVES;
    unsigned char* ws = args.ws;
    const float* x_in = args.in[0];
    float* X = args.out;
    bf16* WinT = (bf16*)(ws + WS_WIN); bf16* WoutT = (bf16*)(ws + WS_WOUT); bf16* WupT = (bf16*)(ws + WS_WUP); bf16* WdnT = (bf16*)(ws + WS_WDN);
    bf16* XN = (bf16*)(ws + WS_XN); bf16* PROJ = (bf16*)(ws + WS_PROJ); bf16* MIX = (bf16*)(ws + WS_MIX); bf16* U = (bf16*)(ws + WS_U);
    volatile LAS unsigned* MISC = (volatile LAS unsigned*)(lds + MISC_OFF);
    if (tid0 < 16) MISC[tid0] = 0u;
    unsigned* barw = (unsigned*)(ws + WS_BAR);
    if (bx == 0) for (int u = tid0; u < XCD_BAR_WORDS; u += NT) barw[u] = 0u;
    __syncthreads();
    XcdBarrier xbar; xbar.bar = barw; xbar.x = 0; xbar.st = MISC;
    bf16* KVS = (bf16*)(ws + WS_KVS); float* DEC = (float*)(ws + WS_DEC); float* SSQ = (float*)ws;

#pragma unroll 1
    for (int l = 0; l < DEPTH; ++l) {
        int tid = tid0; asm volatile("" : "+v"(tid));
        const int lane = tid & 63;
        const float* n1g = args.in[1] + (size_t)l * DM;
        const float* w_in = args.in[2] + (size_t)l * DM * INW;
        const float* qng = args.in[3] + l * 64; const float* kng = args.in[4] + l * 64; const float* sinks = args.in[5] + l * 16;
        const float* ggw = args.in[6] + (size_t)l * 16 * 512; const float* ggb = args.in[7] + l * 512; const float* gng = args.in[8] + l * 256;
        const float* w_out = args.in[9] + (size_t)l * DM * DM; const float* n2g = args.in[10] + (size_t)l * DM;
        const float* w_up = args.in[11] + (size_t)l * DM * DFF; const float* w_dn = args.in[12] + (size_t)l * DFF * DM;
        const float* xsrc = (l == 0) ? x_in : X;
        const ConvCtx cx{w_out, w_up, w_dn, WoutT, WupT, WdnT};

        {
            LAS float* scr = (LAS float*)(lds + wid * 16512);
            constexpr int I_IN = (DM / 32) * (LDP / 128);
#pragma unroll 1
            for (int it = gw; it < I_IN; it += NGW) transpose_item(w_in, DM, INW, LDP, WinT, scr, it, lane);
            if (l == 0) {
#pragma unroll 1
                for (int m = gw; m < M; m += NGW) prep_row(x_in + (size_t)m * DM, n1g, XN + (size_t)m * DM, SSQ + m, lane);
#pragma unroll 1
                for (int e0 = bx * NT; e0 < 3 * M; e0 += G * NT) { const int e = e0 + tid; if (e < 3 * M) SSQ[M + e] = 0.f; }
            }
        }
        if (l == 0) { grid.sync(); xbar = xcd_barrier_post(barw, MISC); } else xcd_barrier(xbar);
#ifndef NO_P1
        { pg8::Gemm g{XN, WinT, M, LDP, DM}; pg8::StaticOrder S; S.init(M, LDP, G, bx); pg8::EpiBf16<0> E{PROJ, LDP, SSQ + (size_t)(2 * l) * M};
          pg8::gemm_phase<pg8::EpiBf16<0>, pg8::StaticOrder, true, true, true>(lds, g, S, E); }
#endif
        xcd_barrier(xbar);
#ifndef NO_ATTN
#pragma unroll 1
        for (int it = bx; it < 512; it += G) attn_item(lds, it, PROJ, MIX, qng, kng, sinks, cx, it, tid, lane, wid);
#endif
#ifndef NO_GLAL
        {
#pragma unroll 1
            for (int g = bx; g < 256; g += G) { float gwr[16]; const int hh = g & 3;
#pragma unroll
                for (int r = 0; r < 16; ++r) gwr[r] = ggw[r * 512 + hh * 128 + (tid & 127)];
                gla_local_group(lds, g, PROJ, KVS, DEC, gwr, ggb[hh * 128 + (tid & 127)], cx, 512 + 2 * g, tid, lane, wid); }
        }
#endif
        xcd_barrier(xbar);
#pragma unroll 1
        for (int e = bx * NT + tid; e < 131072; e += G * NT) {
            const int bh = e >> 14, rem = (e & 16383) * 2, dk = rem & 127;
            unsigned* p = (unsigned*)(KVS + (size_t)bh * 32 * 32768 + rem); const pg8::f32x2_t* d = (const pg8::f32x2_t*)(DEC + (size_t)bh * 32 * 128 + dk);
            float s0 = 0.f, s1 = 0.f; unsigned ub[2][16]; pg8::f32x2_t db[2][16];
#pragma unroll
            for (int nb = 0; nb < 2; ++nb)
#pragma unroll
                for (int i = 0; i < 16; ++i) { ub[nb][i] = p[(size_t)(nb * 16 + i) * 16384]; db[nb][i] = d[(nb * 16 + i) * 64]; }
#pragma unroll
            for (int nb = 0; nb < 2; ++nb)
#pragma unroll
                for (int i = 0; i < 16; ++i) { const unsigned u = ub[nb][i]; const pg8::f32x2_t dd = db[nb][i]; p[(size_t)(nb * 16 + i) * 16384] = pk(s0, s1); s0 = s0 * dd.x + bflo(u); s1 = s1 * dd.y + bfhi(u); }
        }
        xcd_barrier(xbar);
#ifndef NO_GLAO
#pragma unroll 1
        for (int g = bx; g < 256; g += G) gla_out_group(lds, g, PROJ, KVS, MIX, ggw, ggb, gng, tid, lane, wid);
#endif
        xcd_barrier(xbar);
#ifndef NO_P3
        { pg8::Gemm g{MIX, WoutT, M, DM, DM}; pg8::StaticOrder S; S.init(M, DM, G, bx); pg8::EpiRes<true> E{xsrc, X, DM, n2g, XN, SSQ + (size_t)(2 * l + 1) * M};
          pg8::gemm_phase<pg8::EpiRes<true>, pg8::StaticOrder, true, true, true>(lds, g, S, E); }
#endif
        xcd_barrier(xbar);
#ifndef NO_P4
        { pg8::Gemm g{XN, WupT, M, DFF, DM}; pg8::StaticOrder S; S.init(M, DFF, G, bx); pg8::EpiBf16<2> E{U, DFF, SSQ + (size_t)(2 * l + 1) * M};
          pg8::gemm_phase<pg8::EpiBf16<2>, pg8::StaticOrder, true, true, true>(lds, g, S, E); }
#endif
        xcd_barrier(xbar);
#ifndef NO_P5
        { pg8::Gemm g{U, WdnT, M, DM, DFF}; pg8::StaticOrder S; S.init(M, DM, G, bx);
          if (l + 1 < DEPTH) { pg8::EpiRes<true> E{X, X, DM, n1g + DM, XN, SSQ + (size_t)(2 * l + 2) * M}; pg8::gemm_phase<pg8::EpiRes<true>, pg8::StaticOrder, true, true, true>(lds, g, S, E); }
          else { pg8::EpiRes<false> E{X, X, DM, nullptr, nullptr, nullptr}; pg8::gemm_phase<pg8::EpiRes<false>, pg8::StaticOrder, true, true, true>(lds, g, S, E); } }
#endif
        if (l + 1 < DEPTH) xcd_barrier(xbar);
    }
}

extern "C" void kernel_launch(void* const* d_in, const int* in_sizes, int n_in, void* d_out, int out_size, void* d_ws, size_t ws_size, hipStream_t stream) {
    static int grid = 0;
    if (grid == 0) {
        if (n_in != 13 || out_size != M * DM || ws_size < WS_END) { fprintf(stderr, "kernel_launch: unexpected shapes (n_in %d out %d ws %zu)\n", n_in, out_size, ws_size); grid = -1; return; }
        int dev = 0, cus = 0, per_cu = 0;
        (void)hipGetDevice(&dev); (void)hipDeviceGetAttribute(&cus, hipDeviceAttributeMultiprocessorCount, dev);
        (void)hipFuncSetAttribute((const void*)hybrid_fwd, hipFuncAttributeMaxDynamicSharedMemorySize, LDS_BYTES);
        if (hipOccupancyMaxActiveBlocksPerMultiprocessor(&per_cu, (const void*)hybrid_fwd, NT, LDS_BYTES) != hipSuccess || per_cu < 1) per_cu = 1;
        (void)hipGetLastError();
        grid = cus * per_cu;
    }
    if (grid < 0) return;
    Args a{};
    for (int i = 0; i < 13; ++i) a.in[i] = (const float*)d_in[i];
    a.out = (float*)d_out; a.ws = (unsigned char*)d_ws;
    void* kargs[] = {&a};
    hipError_t e = hipLaunchCooperativeKernel((const void*)hybrid_fwd, dim3(grid), dim3(NT), kargs, LDS_BYTES, stream);
    if (e != hipSuccess) fprintf(stderr, "cooperative launch failed: %s (grid %d)\n", hipGetErrorString(e), grid);
}
```

```cpp
#include <hip/hip_runtime.h>
#include <hip/hip_cooperative_groups.h>
#include <cstdio>
#include <cstdint>
namespace cg = cooperative_groups;
namespace pg8 {
#define PG8_LAS __attribute__((address_space(3)))
typedef unsigned short bf16_t;
typedef short bf16x8 __attribute__((ext_vector_type(8)));
typedef float f32x4 __attribute__((ext_vector_type(4)));
typedef unsigned u32x4 __attribute__((ext_vector_type(4)));
constexpr int BM = 256, BK = 64, HALF = 128, HTB = HALF * BK * 2  , STAGE_BYTES = 8 * HTB, NXCD = 8, WGM = 8;

__host__ __device__ __forceinline__ int lds_byte(int r, int c) { const int st = (r >> 4) * 2 + (c >> 5), rr = r & 15, cc = c & 31, ob = rr * 64 + cc * 2; return st * 1024 + (ob ^ (((ob >> 9) & 1) << 5)); }
__host__ __device__ __forceinline__ void stage_rc(int b, int& R, int& C) { const int st = b / 1024, sb = b % 1024, swz = sb ^ (((sb >> 9) & 1) << 5); R = (st >> 1) * 16 + swz / 64; C = (st & 1) * 32 + (swz % 64) / 2; }
__host__ __device__ __forceinline__ int perm32(int rho) { const int n = rho >> 4, i = rho & 15; return 8 * (i >> 2) + 4 * n + (i & 3); }

struct Unit { int pm, pn; };
struct Gemm { const bf16_t* A; const bf16_t* Bt; int M, N, K; };

struct StaticOrder {
    int nM, nN, nwg, G, c;
    __host__ __device__ void init(int M, int N, int G_, int c_) { nM = M / BM; nN = N / BM; nwg = nM * nN; G = G_; c = c_; }
    __host__ __device__ bool next(int i, Unit& u) const {
        const long L = (long)i * G + c; if (L >= nwg) return false;
        int wgid = (int)L; { const int q = nwg / NXCD, r = nwg % NXCD, xcd = wgid % NXCD, off = wgid / NXCD; wgid = (xcd < r ? xcd * (q + 1) : r * (q + 1) + (xcd - r) * q) + off; }
        const int nig = WGM * nN, gid = wgid / nig, fm = gid * WGM, gsz = (nM - fm) < WGM ? (nM - fm) : WGM;
        u.pm = fm + ((wgid % nig) % gsz); u.pn = (wgid % nig) / gsz; return true;
    }
    __device__ __forceinline__ void a_ready(const Unit&) const {}
    __device__ __forceinline__ void done(const Unit&) const {}
};
typedef float f32x2_t __attribute__((ext_vector_type(2))); typedef __bf16 bf16x2_t __attribute__((ext_vector_type(2)));
__device__ __forceinline__ unsigned cvt_pk_bf16(float lo, float hi) { f32x2_t v = {lo, hi}; bf16x2_t b = __builtin_convertvector(v, bf16x2_t); return __builtin_bit_cast(unsigned, b); }
template <int ACT  > struct EpiBf16 {
    static constexpr bool PERM = true, AFTER_DRAIN = false;
    bf16_t* O; int ldc; const float* SSQ;
    __device__ __forceinline__ void operator()(const f32x4 (&acc)[2][2][4][2], const Unit& u, int wr, int wc, int fr, int fq) const {
        const int row0 = u.pm * BM + wr * 64 + fr; const int col0 = u.pn * BM + wc * 32 + 8 * fq;
        float rsv[2][4];
#pragma unroll
        for (int ai = 0; ai < 2; ++ai)
#pragma unroll
            for (int m = 0; m < 4; ++m) rsv[ai][m] = SSQ[row0 + ai * HALF + m * 16];
#pragma unroll
        for (int ai = 0; ai < 2; ++ai)
#pragma unroll
            for (int m = 0; m < 4; ++m) { const int row = row0 + ai * HALF + m * 16; bf16_t* rowp = O + (size_t)row * ldc + col0;
                const float rs = rsqrtf(rsv[ai][m] * (1.0f / 2048.0f) + 1e-6f);
#pragma unroll
                for (int bj = 0; bj < 2; ++bj) { f32x4 v0 = acc[ai][bj][m][0] * rs, v1 = acc[ai][bj][m][1] * rs;
                    if (ACT == 2) { const f32x4 z = {0.f, 0.f, 0.f, 0.f}; v0 = __builtin_elementwise_max(v0, z); v1 = __builtin_elementwise_max(v1, z); v0 = v0 * v0; v1 = v1 * v1; }
                    u32x4 w; w.x = cvt_pk_bf16(v0[0], v0[1]); w.y = cvt_pk_bf16(v0[2], v0[3]); w.z = cvt_pk_bf16(v1[0], v1[1]); w.w = cvt_pk_bf16(v1[2], v1[3]);
                    *(u32x4*)(rowp + bj * HALF) = w; } }
    }
};
template <bool NORM> struct EpiRes {
    static constexpr bool PERM = true, AFTER_DRAIN = false;
    const float* base; float* out; int ldc; const float* g; bf16_t* XG; float* SSQ;
    __device__ __forceinline__ void operator()(const f32x4 (&acc)[2][2][4][2], const Unit& u, int wr, int wc, int fr, int fq) const {
        const int col0 = u.pn * BM + wc * 32 + 8 * fq;
        f32x4 gv[2][2];
        if (NORM) {
#pragma unroll
            for (int bj = 0; bj < 2; ++bj)
#pragma unroll
                for (int n = 0; n < 2; ++n) gv[bj][n] = *(const f32x4*)(g + col0 + bj * HALF + 4 * n); }
#pragma unroll
        for (int ai = 0; ai < 2; ++ai)
#pragma unroll
        for (int mh = 0; mh < 2; ++mh) {
            f32x4 bs[2][2][2];
#pragma unroll
            for (int m2 = 0; m2 < 2; ++m2) { const size_t off = (size_t)(u.pm * BM + ai * HALF + wr * 64 + (2 * mh + m2) * 16 + fr) * ldc + col0;
#pragma unroll
                for (int bj = 0; bj < 2; ++bj)
#pragma unroll
                    for (int n = 0; n < 2; ++n) bs[m2][bj][n] = *(const f32x4*)(base + off + bj * HALF + 4 * n); }
#pragma unroll
            for (int m2 = 0; m2 < 2; ++m2) { const int m = 2 * mh + m2; const int row = u.pm * BM + ai * HALF + wr * 64 + m * 16 + fr; const size_t off = (size_t)row * ldc + col0;
                float ss = 0.f;
#pragma unroll
                for (int bj = 0; bj < 2; ++bj) { const f32x4 v0 = bs[m2][bj][0] + acc[ai][bj][m][0], v1 = bs[m2][bj][1] + acc[ai][bj][m][1];
                    *(f32x4*)(out + off + bj * HALF) = v0; *(f32x4*)(out + off + bj * HALF + 4) = v1;
                    if (NORM) { ss += (v0[0] * v0[0] + v0[1] * v0[1]) + (v0[2] * v0[2] + v0[3] * v0[3]) + (v1[0] * v1[0] + v1[1] * v1[1]) + (v1[2] * v1[2] + v1[3] * v1[3]);
                        const f32x4 y0 = v0 * gv[bj][0], y1 = v1 * gv[bj][1];
                        u32x4 w; w.x = cvt_pk_bf16(y0[0], y0[1]); w.y = cvt_pk_bf16(y0[2], y0[3]); w.z = cvt_pk_bf16(y1[0], y1[1]); w.w = cvt_pk_bf16(y1[2], y1[3]);
                        *(u32x4*)(XG + off + bj * HALF) = w; } }
                if (NORM) { ss += __shfl_xor(ss, 16); ss += __shfl_xor(ss, 32); if (fq == 0) unsafeAtomicAdd(SSQ + row, ss); } }
            asm volatile("" ::: "memory"); }
    }
};
template <class Epi, class Sched, bool ALIGN_EPI = false, bool SP2 = false>
__device__ __forceinline__ void gemm_phase(PG8_LAS unsigned char* lds, const Gemm g, const Sched& S, const Epi& E) {
    int tid_ = threadIdx.x; asm volatile("" : "+v"(tid_));
    const int tid = tid_, wid = __builtin_amdgcn_readfirstlane(tid >> 6), lane = tid & 63, wr = wid >> 2, wc = wid & 3, fr = lane & 15, fq = lane >> 4;
    const int K = g.K, nt = K / BK;
    unsigned voffA[2], voffB[2];
#pragma unroll
    for (int i = 0; i < 2; ++i) { int R, C; stage_rc(tid * 16 + i * 8192, R, C); const int Rb = Epi::PERM ? ((R & ~31) + perm32(R & 31)) : R;
        voffA[i] = (unsigned)(R * K + C) * 2u; voffB[i] = (unsigned)(Rb * K + C) * 2u; }
    const size_t kstep = (size_t)(BK * 2);
    const size_t hstep = (size_t)HALF * K * 2;
    const size_t tstep = 2 * hstep;
    const unsigned ldsw = (unsigned)wid * 1024u;
    const int aoff = lds_byte(wr * 64 + fr, fq * 8), boff = lds_byte(wc * 32 + fr, fq * 8);
#define PG8_SA(b, h) (((b) * 2 + (h)) * HTB)
#define PG8_SB(b, h) ((4 + (b) * 2 + (h)) * HTB)
#define PG8_STAGE(bufoff, gbase, voff) do { _Pragma("unroll") for (int _i = 0; _i < 2; ++_i) \
        __builtin_amdgcn_global_load_lds((const unsigned*)((const char*)(gbase) + (voff)[_i]), (PG8_LAS unsigned*)(lds + (bufoff) + ldsw + _i * 8192), 16, 0, 0); } while (0)
#define PG8_LDA(dst, b, h) do { _Pragma("unroll") for (int m = 0; m < 4; ++m) _Pragma("unroll") for (int k = 0; k < 2; ++k) dst[m][k] = *(const PG8_LAS bf16x8*)(lds + PG8_SA(b, h) + aoff + m * 2048 + k * 1024); } while (0)
#define PG8_LDB(dst, b, h) do { _Pragma("unroll") for (int n = 0; n < 2; ++n) _Pragma("unroll") for (int k = 0; k < 2; ++k) dst[n][k] = *(const PG8_LAS bf16x8*)(lds + PG8_SB(b, h) + boff + n * 2048 + k * 1024); } while (0)
#define PG8_MMA(ai, bj, At, Bt) do { __builtin_amdgcn_s_setprio(1); _Pragma("unroll") for (int m = 0; m < 4; ++m) _Pragma("unroll") for (int n = 0; n < 2; ++n) _Pragma("unroll") for (int k = 0; k < 2; ++k) \
        acc[ai][bj][m][n] = __builtin_amdgcn_mfma_f32_16x16x32_bf16(Bt[n][k], At[m][k], acc[ai][bj][m][n], 0, 0, 0); __builtin_amdgcn_s_setprio(0); } while (0)
#define PG8_WAIT_V(n) asm volatile("s_waitcnt vmcnt(" #n ")" ::: "memory")
#define PG8_WAIT_L(n) asm volatile("s_waitcnt lgkmcnt(" #n ")" ::: "memory")
#define PG8_BAR __builtin_amdgcn_s_barrier()
#define PG8_SCHED __builtin_amdgcn_sched_barrier(0)
    Unit cur, nxt; int ui = 0;
    if (!S.next(0, cur)) return;
    f32x4 acc[2][2][4][2];
#pragma unroll
    for (int a = 0; a < 2; ++a)
#pragma unroll
        for (int b = 0; b < 2; ++b)
#pragma unroll
            for (int m = 0; m < 4; ++m)
#pragma unroll
                for (int n = 0; n < 2; ++n) acc[a][b][m][n] = (f32x4){0.f, 0.f, 0.f, 0.f};
    bf16x8 At[4][2], B0[2][2], B1[2][2];
    const char* cA = (const char*)g.A + (size_t)cur.pm * tstep; const char* cB = (const char*)g.Bt + (size_t)cur.pn * tstep;
    S.a_ready(cur);
    if constexpr (SP2) {
        PG8_STAGE(PG8_SB(0, 0), cB, voffB); PG8_STAGE(PG8_SB(0, 1), cB + hstep, voffB); PG8_STAGE(PG8_SA(0, 0), cA, voffA); PG8_STAGE(PG8_SA(0, 1), cA + hstep, voffA);
        if (wr == 1) PG8_BAR;
        PG8_WAIT_V(2); PG8_BAR;
        PG8_STAGE(PG8_SB(1, 0), cB + kstep, voffB); PG8_STAGE(PG8_SA(1, 0), cA + kstep, voffA); PG8_STAGE(PG8_SB(1, 1), cB + hstep + kstep, voffB);
        PG8_WAIT_V(6); PG8_BAR;
    } else {
        PG8_STAGE(PG8_SB(0, 0), cB, voffB); PG8_STAGE(PG8_SA(0, 0), cA, voffA); PG8_STAGE(PG8_SB(0, 1), cB + hstep, voffB); PG8_STAGE(PG8_SA(0, 1), cA + hstep, voffA);
        if (wr == 1) PG8_BAR;
        PG8_WAIT_V(4); PG8_BAR;
        PG8_STAGE(PG8_SB(1, 0), cB + kstep, voffB); PG8_STAGE(PG8_SA(1, 0), cA + kstep, voffA); PG8_STAGE(PG8_SB(1, 1), cB + hstep + kstep, voffB);
        PG8_WAIT_V(6); PG8_BAR;
    }
    for (;;) {
        const bool has_next = S.next(ui + 1, nxt);
        const char* nA = has_next ? (const char*)g.A + (size_t)nxt.pm * tstep : cA; const char* nB = has_next ? (const char*)g.Bt + (size_t)nxt.pn * tstep : cB;
        for (int t = 0; t < nt; t += 2) {
            const bool last = (t == nt - 2);
            const char* a1 = cA + (size_t)(t + 1) * kstep;
            const char* a2 = last ? nA : cA + (size_t)(t + 2) * kstep; const char* b2 = last ? nB : cB + (size_t)(t + 2) * kstep;
            const char* a3 = a2 + kstep; const char* b3 = b2 + kstep;
            if (last && has_next) S.a_ready(nxt);
            if constexpr (SP2) {
            PG8_LDB(B0, 0, 0); PG8_LDB(B1, 0, 1); PG8_SCHED; PG8_LDA(At, 0, 0); PG8_STAGE(PG8_SA(1, 1), a1 + hstep, voffA);
            PG8_WAIT_V(8); PG8_WAIT_L(0); PG8_BAR; PG8_MMA(0, 0, At, B0); PG8_MMA(0, 1, At, B1); PG8_BAR; PG8_SCHED;
            PG8_LDA(At, 0, 1); PG8_STAGE(PG8_SB(0, 0), b2, voffB); PG8_STAGE(PG8_SB(0, 1), b2 + hstep, voffB); PG8_STAGE(PG8_SA(0, 0), a2, voffA);
            PG8_WAIT_V(8); PG8_WAIT_L(0); PG8_BAR; PG8_MMA(1, 0, At, B0); PG8_MMA(1, 1, At, B1); PG8_BAR; PG8_SCHED;
            PG8_LDB(B0, 1, 0); PG8_LDB(B1, 1, 1); PG8_SCHED; PG8_LDA(At, 1, 0); PG8_STAGE(PG8_SA(0, 1), a2 + hstep, voffA);
            PG8_WAIT_V(8); PG8_WAIT_L(0); PG8_BAR; PG8_MMA(0, 0, At, B0); PG8_MMA(0, 1, At, B1); PG8_BAR; PG8_SCHED;
            PG8_LDA(At, 1, 1); PG8_STAGE(PG8_SB(1, 0), b3, voffB); PG8_STAGE(PG8_SB(1, 1), b3 + hstep, voffB); PG8_STAGE(PG8_SA(1, 0), a3, voffA);
            PG8_WAIT_V(8); PG8_WAIT_L(0); PG8_BAR; PG8_MMA(1, 0, At, B0); PG8_MMA(1, 1, At, B1); PG8_BAR; PG8_SCHED;
            } else {
            PG8_LDB(B0, 0, 0); PG8_SCHED; PG8_LDA(At, 0, 0); PG8_STAGE(PG8_SA(1, 1), a1 + hstep, voffA);
            PG8_WAIT_L(8); PG8_BAR; PG8_WAIT_L(0); PG8_MMA(0, 0, At, B0); PG8_BAR; PG8_SCHED;
            PG8_LDB(B1, 0, 1); PG8_STAGE(PG8_SB(0, 0), b2, voffB);
            PG8_BAR; PG8_WAIT_L(0); PG8_MMA(0, 1, At, B1); PG8_BAR;
            PG8_LDA(At, 0, 1); PG8_STAGE(PG8_SA(0, 0), a2, voffA);
            PG8_BAR; PG8_WAIT_L(0); PG8_MMA(1, 0, At, B0); PG8_BAR; PG8_SCHED;
            PG8_STAGE(PG8_SB(0, 1), b2 + hstep, voffB);
            PG8_WAIT_V(6); PG8_BAR; PG8_MMA(1, 1, At, B1); PG8_BAR;
            PG8_LDB(B0, 1, 0); PG8_SCHED; PG8_LDA(At, 1, 0); PG8_STAGE(PG8_SA(0, 1), a2 + hstep, voffA);
            PG8_WAIT_L(8); PG8_BAR; PG8_WAIT_L(0); PG8_MMA(0, 0, At, B0); PG8_BAR; PG8_SCHED;
            PG8_LDB(B1, 1, 1); PG8_STAGE(PG8_SB(1, 0), b3, voffB);
            PG8_BAR; PG8_WAIT_L(0); PG8_MMA(0, 1, At, B1); PG8_BAR;
            PG8_LDA(At, 1, 1); PG8_STAGE(PG8_SA(1, 0), a3, voffA);
            PG8_BAR; PG8_WAIT_L(0); PG8_MMA(1, 0, At, B0); PG8_BAR; PG8_SCHED;
            PG8_STAGE(PG8_SB(1, 1), b3 + hstep, voffB);
            PG8_WAIT_V(6); PG8_BAR; PG8_MMA(1, 1, At, B1); PG8_BAR;
            }
        }
        if constexpr (ALIGN_EPI) { if (wr == 0) PG8_BAR; }
        if constexpr (!Epi::AFTER_DRAIN) { E(acc, cur, wr, wc, fr, fq); S.done(cur); }
        if (!has_next) break;
#pragma unroll
        for (int a = 0; a < 2; ++a)
#pragma unroll
            for (int b = 0; b < 2; ++b)
#pragma unroll
                for (int m = 0; m < 4; ++m)
#pragma unroll
                    for (int n = 0; n < 2; ++n) acc[a][b][m][n] = (f32x4){0.f, 0.f, 0.f, 0.f};
        cur = nxt; cA = nA; cB = nB; ++ui;
        if constexpr (ALIGN_EPI) { if (wr == 1) PG8_BAR; }
    }
    PG8_WAIT_V(0);
    if constexpr (!ALIGN_EPI) { if (wr == 0) PG8_BAR; }
    PG8_BAR;
    if constexpr (Epi::AFTER_DRAIN) { E.fused(acc, cur, wr, wc, fr, fq, lds, wid, lane); S.done(cur); }
#undef PG8_SA
#undef PG8_SB
#undef PG8_STAGE
#undef PG8_LDA
#undef PG8_LDB
#undef PG8_MMA
#undef PG8_WAIT_V
#undef PG8_WAIT_L
#undef PG8_BAR
#undef PG8_SCHED
}
}
constexpr int SEQ = 8192, DM = 2048, M = 16384, DEPTH = 2, INW = 4624, LDP = 4864, DFF = 8192;
constexpr int C_AQ = 0, C_AK = 1024, C_AV = 1280, C_GQ = 1536, C_GK = 2048, C_GV = 2560, C_GR = 3584, C_GZ = 4608;
constexpr float EPS = 1e-6f;
constexpr int NWAVES = 8, NT = 512;
constexpr size_t MiB = 1u << 20;
constexpr size_t WS_WIN = 1 * MiB, WS_WOUT = 20 * MiB, WS_WUP = 28 * MiB, WS_WDN = 60 * MiB, WS_XN = 92 * MiB;
constexpr size_t WS_U = 156 * MiB, WS_PROJ = 156 * MiB, WS_MIX = 308 * MiB, WS_KVS = 412 * MiB, WS_DEC = 476 * MiB, WS_END = 477 * MiB;
static_assert(WS_PROJ + (size_t)M * LDP * 2 <= WS_MIX && WS_MIX + (size_t)M * DM * 2 <= WS_KVS && WS_U + (size_t)M * DFF * 2 <= WS_KVS, "ws map");
constexpr int LDS_BYTES = 147456;

#define LAS __attribute__((address_space(3)))
typedef unsigned short bf16;
typedef float f32x4 __attribute__((ext_vector_type(4)));
typedef float f32x16 __attribute__((ext_vector_type(16)));
typedef short bf16x8 __attribute__((ext_vector_type(8)));
typedef unsigned u32x4 __attribute__((ext_vector_type(4)));
typedef unsigned u32x2 __attribute__((ext_vector_type(2)));
#define MFMA32(a, b, c) __builtin_amdgcn_mfma_f32_32x32x16_bf16((a), (b), (c), 0, 0, 0)

__device__ __forceinline__ float bflo(unsigned u) { return __uint_as_float(u << 16); }
__device__ __forceinline__ float bfhi(unsigned u) { return __uint_as_float(u & 0xffff0000u); }
__device__ __forceinline__ unsigned pk(float lo, float hi) { return pg8::cvt_pk_bf16(lo, hi); }
__device__ __forceinline__ float wave_sum(float v) {
#pragma unroll
    for (int o = 1; o < 64; o <<= 1) v += __shfl_xor(v, o);
    return v;
}

__device__ __forceinline__ void transpose_item(const float* W, int K, int Nsrc, int Npad, bf16* WT, LAS float* scr, int item, int lane) {
    const int nblk = Npad / 128, kb = item / nblk, nb = item % nblk, k0 = 32 * kb, n0 = 128 * nb;
    const int nl = (lane & 31) * 4, kr = lane >> 5; const bool ok = (n0 + nl) < Nsrc;
    f32x4 v[16];
#pragma unroll
    for (int i = 0; i < 16; ++i) v[i] = ok ? __builtin_nontemporal_load((const f32x4*)(W + (size_t)(k0 + 2 * i + kr) * Nsrc + n0 + nl)) : (f32x4){0.f, 0.f, 0.f, 0.f};
#pragma unroll
    for (int i = 0; i < 16; ++i) { LAS float* s = scr + (2 * i + kr) * 129 + nl; s[0] = v[i].x; s[1] = v[i].y; s[2] = v[i].z; s[3] = v[i].w; }
    asm volatile("s_waitcnt lgkmcnt(0)" ::: "memory");
    const int nn = lane >> 2, kq = lane & 3;
#pragma unroll
    for (int j = 0; j < 8; ++j) { const int n = j * 16 + nn; const LAS float* s = scr + (kq * 8) * 129 + n;
        u32x4 o; o.x = pk(s[0 * 129], s[1 * 129]); o.y = pk(s[2 * 129], s[3 * 129]); o.z = pk(s[4 * 129], s[5 * 129]); o.w = pk(s[6 * 129], s[7 * 129]);
        *(u32x4*)(WT + (size_t)(n0 + n) * K + k0 + kq * 8) = o; }
    asm volatile("s_waitcnt lgkmcnt(0)" ::: "memory");
}
__device__ __forceinline__ void prep_row(const float* xrow, const float* g, bf16* orow, float* ssq, int lane) {
    const f32x4* xr = (const f32x4*)xrow + lane; f32x4 v[8]; float s = 0.f;
#pragma unroll
    for (int j = 0; j < 8; ++j) { v[j] = __builtin_nontemporal_load(xr + 64 * j); s += (v[j].x * v[j].x + v[j].y * v[j].y) + (v[j].z * v[j].z + v[j].w * v[j].w); }
    s = wave_sum(s); if (lane == 0) *ssq = s;
    u32x2* o8 = (u32x2*)orow + lane; const f32x4* gr = (const f32x4*)g + lane;
#pragma unroll
    for (int j = 0; j < 8; ++j) { const f32x4 gg = gr[64 * j]; u32x2 w; w.x = pk(v[j].x * gg.x, v[j].y * gg.y); w.y = pk(v[j].z * gg.z, v[j].w * gg.w); o8[64 * j] = w; }
}

constexpr int CONV_NQ = 2304;
struct ConvJob { const float* W; bf16* WT; int K, N; };
__device__ __forceinline__ bool conv_decode(int q, const float* w_out, const float* w_up, const float* w_dn, bf16* WoutT, bf16* WupT, bf16* WdnT, ConvJob& j, int& k0, int& n0) {
    if (q >= CONV_NQ) return false;
    if (q < 256) { j.W = w_out; j.WT = WoutT; j.K = DM; j.N = DM; k0 = (q >> 3) * 64; n0 = (q & 7) * 256; }
    else if (q < 1280) { const int r = q - 256; j.W = w_up; j.WT = WupT; j.K = DM; j.N = DFF; k0 = (r >> 5) * 64; n0 = (r & 31) * 256; }
    else { const int r = q - 1280; j.W = w_dn; j.WT = WdnT; j.K = DFF; j.N = DM; k0 = (r >> 3) * 64; n0 = (r & 7) * 256; }
    return true;
}
struct ConvCtx { const float* w_out; const float* w_up; const float* w_dn; bf16* WoutT; bf16* WupT; bf16* WdnT; };
__device__ __forceinline__ void conv_load(const ConvCtx& cx, int q, int tid, f32x4 (&v)[8]) {
    ConvJob j; int k0, n0;
    if (!conv_decode(q, cx.w_out, cx.w_up, cx.w_dn, cx.WoutT, cx.WupT, cx.WdnT, j, k0, n0)) return;
    const float* p = j.W + (size_t)(k0 + ((tid & 63) >> 3) * 8) * j.N + n0 + (tid >> 6) * 32 + (tid & 7) * 4;
#pragma unroll
    for (int r = 0; r < 8; ++r) v[r] = __builtin_nontemporal_load((const f32x4*)(p + (size_t)r * j.N));
}
__device__ __forceinline__ void conv_store(const ConvCtx& cx, int q, int tid, const f32x4 (&v)[8]) {
    ConvJob j; int k0, n0;
    if (!conv_decode(q, cx.w_out, cx.w_up, cx.w_dn, cx.WoutT, cx.WupT, cx.WdnT, j, k0, n0)) return;
    bf16* p = j.WT + (size_t)(n0 + (tid >> 6) * 32 + (tid & 7) * 4) * j.K + k0 + ((tid & 63) >> 3) * 8;
#pragma unroll
    for (int i = 0; i < 4; ++i) { u32x4 o; o.x = pk(v[0][i], v[1][i]); o.y = pk(v[2][i], v[3][i]); o.z = pk(v[4][i], v[5][i]); o.w = pk(v[6][i], v[7][i]); *(u32x4*)(p + (size_t)i * j.K) = o; }
}

__device__ __forceinline__ void attn_item(LAS unsigned char* lds, int item, const bf16* PROJ, bf16* MIX, const float* qng, const float* kng, const float* sinks, const ConvCtx& cx, int cq, int tid, int lane, int wid) {
    const int kvh = item & 3, blk = (item >> 2) & 63, b = item >> 8;
    f32x4 cv[8];
    LAS unsigned char* Ks = lds; LAS unsigned short* Vt = (LAS unsigned short*)(lds + 36864);
    const size_t tok0 = (size_t)b * SEQ + (size_t)blk * 128;
    const int g = wid >> 1, rh = wid & 1, qh = kvh * 4 + g, h = lane >> 5, c = lane & 31;
    u32x4 qq[2][4];
    { const bf16* qp = PROJ + (tok0 + rh * 64 + c) * LDP + C_AQ + qh * 64 + h * 8;
#pragma unroll
        for (int kk = 0; kk < 4; ++kk) qq[0][kk] = *(const u32x4*)(qp + 16 * kk); }
    {
        const int key = tid >> 1, hf = tid & 1; const bool ok = (blk > 0) || (key >= 128);
        u32x4 kq[4], vq[4];
        if (ok) { const bf16* p = PROJ + (tok0 + key - 128) * LDP + C_AK + kvh * 64 + hf * 32;
#pragma unroll
            for (int i = 0; i < 4; ++i) { kq[i] = *(const u32x4*)(p + 8 * i); vq[i] = *(const u32x4*)(p + 256 + 8 * i); } }
        else {
#pragma unroll
            for (int i = 0; i < 4; ++i) { kq[i] = (u32x4){0u, 0u, 0u, 0u}; vq[i] = (u32x4){0u, 0u, 0u, 0u}; } }
        conv_load(cx, cq, tid, cv);
        float kf[32]; float ss = 0.f;
#pragma unroll
        for (int i = 0; i < 4; ++i)
#pragma unroll
            for (int c = 0; c < 4; ++c) { kf[i * 8 + 2 * c] = bflo(kq[i][c]); kf[i * 8 + 2 * c + 1] = bfhi(kq[i][c]); }
#pragma unroll
        for (int i = 0; i < 32; ++i) ss += kf[i] * kf[i];
        ss += __shfl_xor(ss, 1);
        const float rstd = rsqrtf(ss * (1.f / 64.f) + EPS);
#pragma unroll
        for (int i = 0; i < 4; ++i) { u32x4 w;
#pragma unroll
            for (int c = 0; c < 4; ++c) { const int d = hf * 32 + i * 8 + 2 * c; w[c] = pk(kf[i * 8 + 2 * c] * rstd * kng[d], kf[i * 8 + 2 * c + 1] * rstd * kng[d + 1]); }
            *(LAS u32x4*)(Ks + key * 144 + hf * 64 + i * 16) = w; }
#pragma unroll
        for (int i = 0; i < 4; ++i)
#pragma unroll
            for (int c = 0; c < 4; ++c) { const int d = hf * 32 + i * 8 + 2 * c; Vt[d * 260 + key] = (unsigned short)(vq[i][c] & 0xffffu); Vt[(d + 1) * 260 + key] = (unsigned short)(vq[i][c] >> 16); }
    }
    __syncthreads();
    conv_store(cx, cq, tid, cv);
    { const bf16* qp = PROJ + (tok0 + rh * 64 + 32 + c) * LDP + C_AQ + qh * 64 + h * 8;
#pragma unroll
        for (int kk = 0; kk < 4; ++kk) qq[1][kk] = *(const u32x4*)(qp + 16 * kk); }
    const float L2E = 1.4426950408889634f;
    const float slope2 = exp2f(-0.5f * (float)(qh + 1)) * L2E, sink2 = sinks[qh] * L2E;
    const int cm = c - 4 * h;
    const float base = -slope2 * (float)cm;
#pragma unroll 1
    for (int sb = 0; sb < 2; ++sb) {
        const int i0 = rh * 64 + sb * 32, qi = i0 + c;
        float qf[32]; float ss = 0.f;
#pragma unroll
        for (int kk = 0; kk < 4; ++kk)
#pragma unroll
            for (int cc = 0; cc < 4; ++cc) { const unsigned qw = sb ? qq[1][kk][cc] : qq[0][kk][cc]; qf[kk * 8 + 2 * cc] = bflo(qw); qf[kk * 8 + 2 * cc + 1] = bfhi(qw); }
#pragma unroll
        for (int i = 0; i < 32; ++i) ss += qf[i] * qf[i];
        ss += __shfl_xor(ss, 32);
        const float rstd = rsqrtf(ss * (1.f / 64.f) + EPS) * (0.125f * L2E);
        bf16x8 qb[4];
#pragma unroll
        for (int kk = 0; kk < 4; ++kk) { u32x4 w;
#pragma unroll
            for (int cc = 0; cc < 4; ++cc) { const int d = h * 8 + 16 * kk + 2 * cc; w[cc] = pk(qf[kk * 8 + 2 * cc] * rstd * qng[d], qf[kk * 8 + 2 * cc + 1] * rstd * qng[d + 1]); }
            qb[kk] = __builtin_bit_cast(bf16x8, w); }
        f32x16 s[5];
#pragma unroll
        for (int T = 0; T < 5; ++T) {
#pragma unroll
            for (int r = 0; r < 16; ++r) s[T][r] = 0.f;
#pragma unroll
            for (int kk = 0; kk < 4; ++kk) { const bf16x8 a = *(const LAS bf16x8*)(Ks + (i0 + 32 * T + c) * 144 + (h * 8 + 16 * kk) * 2); s[T] = MFMA32(a, qb[kk], s[T]); }
        }
        float mx = -1e30f;
#pragma unroll
        for (int T = 0; T < 5; ++T) {
            const bool dead = (blk == 0) && (i0 + 32 * T < 128);
#pragma unroll
            for (int r = 0; r < 16; ++r) { const int ep = 8 * (r >> 2) + (r & 3); float x = __builtin_fmaf(slope2, (float)(32 * T + ep - 128), s[T][r]);
                if (T == 0) x = (ep > cm) ? x : -1e30f;
                if (T == 4) x = (ep <= cm) ? x : -1e30f;
                if (dead) x = -1e30f;
                s[T][r] = x; mx = fmaxf(mx, x); } }
        float mrow = mx + base; mrow = fmaxf(mrow, __shfl_xor(mrow, 32)); mrow = fmaxf(mrow, sink2);
        const float mp = mrow - base;
        float sum = 0.f;
#pragma unroll
        for (int T = 0; T < 5; ++T)
#pragma unroll
            for (int r = 0; r < 16; ++r) { const float p = __builtin_amdgcn_exp2f(s[T][r] - mp); s[T][r] = p; sum += p; }
        sum += __shfl_xor(sum, 32); sum += __builtin_amdgcn_exp2f(sink2 - mrow);
        const float inv = 1.f / sum;
        f32x16 o[2];
#pragma unroll
        for (int mt = 0; mt < 2; ++mt)
#pragma unroll
            for (int r = 0; r < 16; ++r) o[mt][r] = 0.f;
#pragma unroll
        for (int T = 0; T < 5; ++T)
#pragma unroll
            for (int u = 0; u < 2; ++u) { u32x4 w;
#pragma unroll
                for (int cc = 0; cc < 4; ++cc) w[cc] = pk(s[T][8 * u + 2 * cc], s[T][8 * u + 2 * cc + 1]);
                const bf16x8 pb = __builtin_bit_cast(bf16x8, w);
#pragma unroll
                for (int mt = 0; mt < 2; ++mt) { const LAS unsigned short* vp = Vt + (mt * 32 + c) * 260 + i0 + 32 * T + 16 * u + 4 * h;
                    const u32x2 lo = *(const LAS u32x2*)vp, hi = *(const LAS u32x2*)(vp + 8);
                    const u32x4 av = {lo.x, lo.y, hi.x, hi.y}; o[mt] = MFMA32(__builtin_bit_cast(bf16x8, av), pb, o[mt]); } }
        bf16* op = MIX + (tok0 + qi) * DM + qh * 64 + 4 * h;
#pragma unroll
        for (int mt = 0; mt < 2; ++mt)
#pragma unroll
            for (int q4 = 0; q4 < 4; ++q4) { u32x2 w; w.x = pk(o[mt][4 * q4] * inv, o[mt][4 * q4 + 1] * inv); w.y = pk(o[mt][4 * q4 + 2] * inv, o[mt][4 * q4 + 3] * inv); *(u32x2*)(op + mt * 32 + 8 * q4) = w; }
    }
    __syncthreads();
}

constexpr int GL_GZS = 33792, GL_SEG = 37888, GL_QI = 39936, GL_KI = 58368, GL_AT = 75776, GL_VT = 84992;
__device__ __forceinline__ void gla_gate(LAS unsigned char* lds, unsigned gzw, const float (&w)[16], float bias, int tid) {
    LAS float* BsT = (LAS float*)lds; LAS float* gzs = (LAS float*)(lds + GL_GZS); LAS float* seg = (LAS float*)(lds + GL_SEG);
    { const int t = tid >> 3, r2 = (tid & 7) * 2; gzs[t * 16 + r2] = bflo(gzw); gzs[t * 16 + r2 + 1] = bfhi(gzw); }
    const int j = tid & 127, tq = tid >> 7;
    __syncthreads();
    float val[16]; float run = 0.f;
#pragma unroll
    for (int i = 0; i < 16; ++i) { const LAS f32x4* zp = (const LAS f32x4*)(gzs + (tq * 16 + i) * 16); float z = bias;
#pragma unroll
        for (int v = 0; v < 4; ++v) { const f32x4 zz = zp[v]; z += zz.x * w[4 * v] + zz.y * w[4 * v + 1] + zz.z * w[4 * v + 2] + zz.w * w[4 * v + 3]; }
        const float ls = fminf(z, 0.f) - __logf(1.f + __expf(-fabsf(z))); run += ls * (1.f / 16.f); val[i] = run; }
    seg[tq * 128 + j] = run;
    __syncthreads();
    float off = 0.f;
#pragma unroll
    for (int q = 0; q < 3; ++q) if (q < tq) off += seg[q * 128 + j];
#pragma unroll
    for (int i = 0; i < 16; ++i) BsT[j * 65 + tq * 16 + i] = val[i] + off;
    __syncthreads();
}
__device__ __forceinline__ void gla_scatter_vt(LAS unsigned char* lds, const u32x4 (&vq)[4], int tid) {
    LAS unsigned short* VT = (LAS unsigned short*)(lds + GL_VT); const int t = tid & 63, cw = tid >> 6;
#pragma unroll
    for (int i = 0; i < 4; ++i)
#pragma unroll
        for (int e = 0; e < 4; ++e) { const int c = 8 * (cw + 8 * i) + 2 * e; VT[c * 72 + t] = (unsigned short)(vq[i][e] & 0xffffu); VT[(c + 1) * 72 + t] = (unsigned short)(vq[i][e] >> 16); }
}
constexpr int GL_KST = 121856;
__device__ __forceinline__ void gla_stage_kst(LAS unsigned char* lds, LAS unsigned short* KsT, const u32x4 (&kq)[2], int tid) {
    LAS float* BsT = (LAS float*)lds; LAS float* decs = (LAS float*)(lds + GL_SEG); const int t = tid & 63, cw = tid >> 6;
#pragma unroll
    for (int i = 0; i < 2; ++i)
#pragma unroll
        for (int e = 0; e < 4; ++e) { const int j = 8 * (cw + 8 * i) + 2 * e;
            const float e0 = __expf(BsT[j * 65 + 63] - BsT[j * 65 + t]), e1 = __expf(BsT[(j + 1) * 65 + 63] - BsT[(j + 1) * 65 + t]);
            const unsigned w = pk(bflo(kq[i][e]) * e0, bfhi(kq[i][e]) * e1);
            KsT[j * 72 + t] = (unsigned short)(w & 0xffffu); KsT[(j + 1) * 72 + t] = (unsigned short)(w >> 16); }
    if (tid < 128) decs[tid] = __expf(BsT[tid * 65 + 63]);
}
__device__ __forceinline__ void gla_state_update(LAS unsigned char* lds, const LAS unsigned short* KsT, const bf16x8 (&bv)[4], f32x16 (&S)[4], bool first, int h, int c) {
    const LAS float* decs = (const LAS float*)(lds + GL_SEG);
#pragma unroll
    for (int mt = 0; mt < 4; ++mt) { f32x16 acc;
#pragma unroll
        for (int r = 0; r < 16; ++r) acc[r] = 0.f;
#pragma unroll
        for (int ks = 0; ks < 4; ++ks) { const bf16x8 a = *(const LAS bf16x8*)(KsT + (mt * 32 + c) * 72 + h * 8 + 16 * ks); acc = MFMA32(a, bv[ks], acc); }
        if (first) S[mt] = acc;
        else {
#pragma unroll
            for (int q = 0; q < 4; ++q) { const f32x4 d = *(const LAS f32x4*)(decs + mt * 32 + 8 * q + 4 * h);
#pragma unroll
                for (int e = 0; e < 4; ++e) S[mt][4 * q + e] = S[mt][4 * q + e] * d[e] + acc[4 * q + e]; } }
        __builtin_amdgcn_sched_barrier(0); }
}
__device__ __forceinline__ void gla_local_group(LAS unsigned char* lds, int g, const bf16* PROJ, bf16* KVS, float* DEC, const float (&gwr)[16], float gbias, const ConvCtx& cx, int cq0, int tid, int lane, int wid) {
    const int hh = g & 3, gi = (g >> 2) & 31, b = g >> 7; const int t = tid & 63, cw = tid >> 6, h = lane >> 5, c = lane & 31;
    LAS float* BsT = (LAS float*)lds; LAS unsigned short* KsT = (LAS unsigned short*)(lds + GL_QI); LAS unsigned short* VT = (LAS unsigned short*)(lds + GL_VT);
    f32x16 S[4]; float blsum = 0.f;
#pragma unroll 1
    for (int j = 0; j < 4; ++j) {
        const size_t R0 = (size_t)b * SEQ + (size_t)(gi * 4 + j) * 64; const int cq = cq0 + 2 * (j * 256);
        f32x4 cv[8];
        const unsigned gzw = *(const unsigned*)(PROJ + (R0 + (tid >> 3)) * LDP + C_GZ + (tid & 7) * 2);
        u32x4 kq[2], vq[4];
        { const bf16* rp = PROJ + (R0 + t) * LDP;
#pragma unroll
            for (int i = 0; i < 2; ++i) kq[i] = *(const u32x4*)(rp + C_GK + hh * 128 + 8 * (cw + 8 * i));
#pragma unroll
            for (int i = 0; i < 4; ++i) vq[i] = *(const u32x4*)(rp + C_GV + hh * 256 + 8 * (cw + 8 * i)); }
        conv_load(cx, cq, tid, cv);
        gla_gate(lds, gzw, gwr, gbias, tid);
        conv_store(cx, cq, tid, cv);
        conv_load(cx, cq + 1, tid, cv);
        gla_scatter_vt(lds, vq, tid);
        gla_stage_kst(lds, KsT, kq, tid);
        if (tid < 128) blsum += BsT[tid * 65 + 63];
        __syncthreads();
        { bf16x8 bv[4];
#pragma unroll
            for (int ks = 0; ks < 4; ++ks) bv[ks] = *(const LAS bf16x8*)(VT + (wid * 32 + c) * 72 + h * 8 + 16 * ks);
            gla_state_update(lds, KsT, bv, S, j == 0, h, c); }
        conv_store(cx, cq + 1, tid, cv);
        __syncthreads();
    }
    { bf16* outp = KVS + (size_t)((b * 4 + hh) * 32 + gi) * 32768 + (size_t)(wid * 32 + c) * 128 + 4 * h;
#pragma unroll
        for (int mt = 0; mt < 4; ++mt)
#pragma unroll
            for (int q = 0; q < 4; ++q) { u32x2 w; w.x = pk(S[mt][4 * q], S[mt][4 * q + 1]); w.y = pk(S[mt][4 * q + 2], S[mt][4 * q + 3]); *(u32x2*)(outp + mt * 32 + 8 * q) = w; }
        if (tid < 128) DEC[(size_t)((b * 4 + hh) * 32 + gi) * 128 + tid] = __expf(blsum); }
}
__device__ __forceinline__ void gla_out_group(LAS unsigned char* lds, int g, const bf16* PROJ, const bf16* KVS, bf16* MIX, const float* ggw, const float* ggb, const float* gng, int tid_in, int lane_in, int wid) {
    const int hh = g & 3, gi = (g >> 2) & 31, b = g >> 7;
    LAS float* BsT = (LAS float*)lds; LAS unsigned short* Qi = (LAS unsigned short*)(lds + GL_QI); LAS unsigned short* Ki = (LAS unsigned short*)(lds + GL_KI);
    LAS unsigned short* At = (LAS unsigned short*)(lds + GL_AT); LAS unsigned short* VT = (LAS unsigned short*)(lds + GL_VT); LAS float* Ob = (LAS float*)lds;
    LAS unsigned short* KsT = (LAS unsigned short*)(lds + GL_KST);
    f32x16 S[4];
    { const int h = lane_in >> 5, c = lane_in & 31; const bf16* sp = KVS + (size_t)((b * 4 + hh) * 32 + gi) * 32768 + (size_t)(wid * 32 + c) * 128 + 4 * h;
#pragma unroll
        for (int mt = 0; mt < 4; ++mt)
#pragma unroll
            for (int q = 0; q < 4; ++q) { const u32x2 u = *(const u32x2*)(sp + mt * 32 + 8 * q); S[mt][4 * q] = bflo(u.x); S[mt][4 * q + 1] = bfhi(u.x); S[mt][4 * q + 2] = bflo(u.y); S[mt][4 * q + 3] = bfhi(u.y); } }
#pragma unroll 1
    for (int j = 0; j < 4; ++j) {
        int tid = tid_in; asm volatile("" : "+v"(tid));
        const int lane = tid & 63, t = tid & 63, cw = tid >> 6, h = lane >> 5, c = lane & 31;
        const size_t R0 = (size_t)b * SEQ + (size_t)(gi * 4 + j) * 64;
        const unsigned gzw = *(const unsigned*)(PROJ + (R0 + (tid >> 3)) * LDP + C_GZ + (tid & 7) * 2);
        u32x4 qq[2], kq[2], vq[4]; u32x2 grv[8];
        { const bf16* rp = PROJ + (R0 + t) * LDP;
#pragma unroll
            for (int i = 0; i < 2; ++i) { qq[i] = *(const u32x4*)(rp + C_GQ + hh * 128 + 8 * (cw + 8 * i)); kq[i] = *(const u32x4*)(rp + C_GK + hh * 128 + 8 * (cw + 8 * i)); }
#pragma unroll
            for (int i = 0; i < 4; ++i) vq[i] = *(const u32x4*)(rp + C_GV + hh * 256 + 8 * (cw + 8 * i));
        }
        { float gwr[16];
#pragma unroll
            for (int r = 0; r < 16; ++r) gwr[r] = ggw[r * 512 + hh * 128 + (tid & 127)];
            gla_gate(lds, gzw, gwr, ggb[hh * 128 + (tid & 127)], tid); }
        gla_scatter_vt(lds, vq, tid);
        gla_stage_kst(lds, KsT, kq, tid);
        { const float QS = 0.08838834764831845f;
#pragma unroll
            for (int i = 0; i < 2; ++i) { const int j8 = 8 * (cw + 8 * i); u32x4 oq, ok;
#pragma unroll
                for (int e = 0; e < 4; ++e) { const float b0 = BsT[(j8 + 2 * e) * 65 + t], b1 = BsT[(j8 + 2 * e + 1) * 65 + t];
                    oq[e] = pk(bflo(qq[i][e]) * QS * __expf(b0), bfhi(qq[i][e]) * QS * __expf(b1)); ok[e] = pk(bflo(kq[i][e]) * __expf(-b0), bfhi(kq[i][e]) * __expf(-b1)); }
                *(LAS u32x4*)(Qi + t * 136 + j8) = oq; *(LAS u32x4*)(Ki + t * 136 + j8) = ok; } }
        __syncthreads();
        if (wid < 4) { const int mt = wid >> 1, nt = wid & 1; f32x16 acc;
#pragma unroll
            for (int r = 0; r < 16; ++r) acc[r] = 0.f;
#pragma unroll
            for (int ks = 0; ks < 8; ++ks) { const bf16x8 a = *(const LAS bf16x8*)(Qi + (mt * 32 + c) * 136 + h * 8 + 16 * ks), bb = *(const LAS bf16x8*)(Ki + (nt * 32 + c) * 136 + h * 8 + 16 * ks); acc = MFMA32(a, bb, acc); }
#pragma unroll
            for (int r = 0; r < 16; ++r) { const int tt = mt * 32 + 8 * (r >> 2) + 4 * h + (r & 3), ss = nt * 32 + c; At[tt * 72 + ss] = (unsigned short)((ss <= tt) ? (pk(acc[r], 0.f) & 0xffffu) : 0u); } }
        __syncthreads();
        f32x16 o[2]; bf16x8 bv[4];
#pragma unroll
        for (int mt = 0; mt < 2; ++mt)
#pragma unroll
            for (int r = 0; r < 16; ++r) o[mt][r] = 0.f;
#pragma unroll
        for (int ks = 0; ks < 4; ++ks) { bv[ks] = *(const LAS bf16x8*)(VT + (wid * 32 + c) * 72 + h * 8 + 16 * ks);
#pragma unroll
            for (int mt = 0; mt < 2; ++mt) { const bf16x8 a = *(const LAS bf16x8*)(At + (mt * 32 + c) * 72 + h * 8 + 16 * ks); o[mt] = MFMA32(a, bv[ks], o[mt]); } }
#pragma unroll
        for (int ms = 0; ms < 4; ++ms)
#pragma unroll
            for (int u = 0; u < 2; ++u) { u32x4 w;
#pragma unroll
                for (int e = 0; e < 4; ++e) w[e] = pk(S[ms][8 * u + 2 * e], S[ms][8 * u + 2 * e + 1]);
                const bf16x8 sb = __builtin_bit_cast(bf16x8, w);
#pragma unroll
                for (int mt = 0; mt < 2; ++mt) { const LAS unsigned short* qp = Qi + (mt * 32 + c) * 136 + 32 * ms + 16 * u + 4 * h;
                    const u32x2 lo = *(const LAS u32x2*)qp, hi = *(const LAS u32x2*)(qp + 8); const u32x4 av = {lo.x, lo.y, hi.x, hi.y};
                    o[mt] = MFMA32(__builtin_bit_cast(bf16x8, av), sb, o[mt]); }
                __builtin_amdgcn_sched_barrier(0); }
#pragma unroll
        for (int i = 0; i < 8; ++i) grv[i] = *(const u32x2*)(PROJ + (R0 + wid * 8 + i) * LDP + C_GR + hh * 256 + lane * 4);
        gla_state_update(lds, KsT, bv, S, false, h, c);
        __syncthreads();
#pragma unroll
        for (int mt = 0; mt < 2; ++mt)
#pragma unroll
            for (int r = 0; r < 16; ++r) Ob[(mt * 32 + 8 * (r >> 2) + 4 * h + (r & 3)) * 260 + wid * 32 + c] = o[mt][r];
        __syncthreads();
        const f32x4 g4 = *(const f32x4*)(gng + lane * 4);
#pragma unroll
        for (int i = 0; i < 8; ++i) { const int tt = wid * 8 + i; const f32x4 x = *(const LAS f32x4*)(Ob + tt * 260 + lane * 4);
            const float ss = wave_sum((x.x * x.x + x.y * x.y) + (x.z * x.z + x.w * x.w)); const float rstd = rsqrtf(ss * (1.f / 256.f) + EPS);
            const float r0 = bflo(grv[i].x), r1 = bfhi(grv[i].x), r2 = bflo(grv[i].y), r3 = bfhi(grv[i].y);
            u32x2 w; w.x = pk(x.x * rstd * g4.x * (r0 / (1.f + __expf(-r0))), x.y * rstd * g4.y * (r1 / (1.f + __expf(-r1))));
            w.y = pk(x.z * rstd * g4.z * (r2 / (1.f + __expf(-r2))), x.w * rstd * g4.w * (r3 / (1.f + __expf(-r3))));
            *(u32x2*)(MIX + (R0 + tt) * DM + 1024 + hh * 256 + lane * 4) = w; }
        __syncthreads();
    }
}
#define XB_TMO      128
#define XB_XCNT(j)  (256  + 64 * (j))
#define XB_XSUB(j)  (1280 + 64 * (j))
#define XB_XGEN(j)  (2304 + 64 * (j))
#define XB_TOP      3328
#define XB_TOPGEN   3392
#define XCD_BAR_WORDS 3456
#define XB_SPIN_CAP (1u << 18)

__device__ __forceinline__ unsigned xb_ld(unsigned* p)              { return __hip_atomic_load(p, __ATOMIC_RELAXED, __HIP_MEMORY_SCOPE_AGENT); }
__device__ __forceinline__ unsigned xb_add(unsigned* p, unsigned v) { return __hip_atomic_fetch_add(p, v, __ATOMIC_RELAXED, __HIP_MEMORY_SCOPE_AGENT); }
__device__ __forceinline__ unsigned xb_xcc_id() { return (unsigned)__builtin_amdgcn_s_getreg((3 << 11) | 20) & 0xFu; }
#define XB_SPIN(cond, bar) do { unsigned _sp = 0; while (cond) { __builtin_amdgcn_s_sleep(1); \
    if ((++_sp & 255u) == 0u) { if (xb_ld(&(bar)[XB_TMO])) break; if (_sp > XB_SPIN_CAP) { atomicAdd(&(bar)[XB_TMO], 1u); break; } } } } while (0)

struct XcdBarrier {
    unsigned* bar; unsigned x;
    volatile LAS unsigned* st;
};

__device__ __forceinline__ XcdBarrier xcd_barrier_post(unsigned* bar, volatile LAS unsigned* st) {
    XcdBarrier b; b.bar = bar; b.x = xb_xcc_id(); b.st = st;
    if (threadIdx.x == 0) (void)xb_add(&bar[XB_XCNT(b.x)], 1u);
    return b;
}
__device__ __forceinline__ void xcd_barrier_complete(unsigned* bar, unsigned x, unsigned& nloc, unsigned& nx) {
    const unsigned G = gridDim.x * gridDim.y * gridDim.z;
    unsigned sum, cnt, mine, sp = 0u;
    for (;;) {
        sum = 0u; cnt = 0u; mine = 0u;
#pragma unroll
        for (unsigned j = 0; j < 16; ++j) { const unsigned c = xb_ld(&bar[XB_XCNT(j)]); sum += c; cnt += (c > 0u) ? 1u : 0u; mine = (j == x) ? c : mine; }
        if (sum == G) break;
        __builtin_amdgcn_s_sleep(1);
        if ((++sp & 255u) == 0u) { if (xb_ld(&bar[XB_TMO])) break; if (sp > XB_SPIN_CAP) { atomicAdd(&bar[XB_TMO], 1u); break; } }
    }
    nloc = mine > 0u ? mine : 1u; nx = cnt > 0u ? cnt : 1u;
}

__device__ __forceinline__ void xcd_barrier(const XcdBarrier& b) {
    asm volatile("s_waitcnt vmcnt(0)" ::: "memory");
    __syncthreads();
    if (threadIdx.x == 0) {
        unsigned* bar = b.bar;
        __builtin_amdgcn_s_waitcnt(0);
        unsigned nloc = b.st[0], nx = b.st[1];
        if (nloc == 0u) { xcd_barrier_complete(bar, b.x, nloc, nx); b.st[0] = nloc; b.st[1] = nx; }
        const unsigned old = xb_add(&bar[XB_XSUB(b.x)], 1u);
        const unsigned gen = old / nloc;
        if (old + 1u == (gen + 1u) * nloc) {
            __builtin_amdgcn_fence(__ATOMIC_RELEASE, "agent");
            asm volatile("s_waitcnt vmcnt(0)" ::: "memory");
            const unsigned og = xb_add(&bar[XB_TOP], 1u);
            const unsigned tg = og / nx;
            if (og + 1u == (tg + 1u) * nx) xb_add(&bar[XB_TOPGEN], 1u);
            else XB_SPIN(xb_ld(&bar[XB_TOPGEN]) == tg, bar);
            __builtin_amdgcn_fence(__ATOMIC_ACQUIRE, "agent");
            xb_add(&bar[XB_XGEN(b.x)], 1u);
            asm volatile("s_waitcnt vmcnt(0)" ::: "memory");
        } else {
            XB_SPIN(xb_ld(&bar[XB_XGEN(b.x)]) == gen, bar);
            __builtin_amdgcn_fence(__ATOMIC_ACQUIRE, "agent");
            asm volatile("s_waitcnt vmcnt(0)" ::: "memory");
        }
    }
    __syncthreads();
}
constexpr size_t WS_BAR = 512 * 1024;
constexpr int MISC_OFF = LDS_BYTES - 64;
struct Args { const float* in[13]; float* out; unsigned char* ws; };
__global__ void __launch_bounds__(NT, 2) hybrid_fwd(Args args) {
    extern __shared__ __attribute__((aligned(16))) unsigned char lds_raw[];
    cg::grid_group grid = cg::this_grid();
    LAS unsigned char* lds = (LAS unsigned char*)lds_raw;
    const int tid0 = threadIdx.x, wid = __builtin_amdgcn_readfirstlane(tid0 >> 6);
    const int G = gridDim.x, bx = blockIdx.x;
    const int gw = bx * NWAVES + wid, NGW = G * NWAVES;
    unsigned char* ws = args.ws;
    const float* x_in = args.in[0];
    float* X = args.out;
    bf16* WinT = (bf16*)(ws + WS_WIN); bf16* WoutT = (bf16*)(ws + WS_WOUT); bf16* WupT = (bf16*)(ws + WS_WUP); bf16* WdnT = (bf16*)(ws + WS_WDN);
    bf16* XN = (bf16*)(ws + WS_XN); bf16* PROJ = (bf16*)(ws + WS_PROJ); bf16* MIX = (bf16*)(ws + WS_MIX); bf16* U = (bf16*)(ws + WS_U);
    volatile LAS unsigned* MISC = (volatile LAS unsigned*)(lds + MISC_OFF);
    if (tid0 < 16) MISC[tid0] = 0u;
    unsigned* barw = (unsigned*)(ws + WS_BAR);
    if (bx == 0) for (int u = tid0; u < XCD_BAR_WORDS; u += NT) barw[u] = 0u;
    __syncthreads();
    XcdBarrier xbar; xbar.bar = barw; xbar.x = 0; xbar.st = MISC;
    bf16* KVS = (bf16*)(ws + WS_KVS); float* DEC = (float*)(ws + WS_DEC); float* SSQ = (float*)ws;

#pragma unroll 1
    for (int l = 0; l < DEPTH; ++l) {
        int tid = tid0; asm volatile("" : "+v"(tid));
        const int lane = tid & 63;
        const float* n1g = args.in[1] + (size_t)l * DM;
        const float* w_in = args.in[2] + (size_t)l * DM * INW;
        const float* qng = args.in[3] + l * 64; const float* kng = args.in[4] + l * 64; const float* sinks = args.in[5] + l * 16;
        const float* ggw = args.in[6] + (size_t)l * 16 * 512; const float* ggb = args.in[7] + l * 512; const float* gng = args.in[8] + l * 256;
        const float* w_out = args.in[9] + (size_t)l * DM * DM; const float* n2g = args.in[10] + (size_t)l * DM;
        const float* w_up = args.in[11] + (size_t)l * DM * DFF; const float* w_dn = args.in[12] + (size_t)l * DFF * DM;
        const float* xsrc = (l == 0) ? x_in : X;
        const ConvCtx cx{w_out, w_up, w_dn, WoutT, WupT, WdnT};

        {
            LAS float* scr = (LAS float*)(lds + wid * 16512);
            constexpr int I_IN = (DM / 32) * (LDP / 128);
#pragma unroll 1
            for (int it = gw; it < I_IN; it += NGW) transpose_item(w_in, DM, INW, LDP, WinT, scr, it, lane);
            if (l == 0) {
#pragma unroll 1
                for (int m = gw; m < M; m += NGW) prep_row(x_in + (size_t)m * DM, n1g, XN + (size_t)m * DM, SSQ + m, lane);
#pragma unroll 1
                for (int e0 = bx * NT; e0 < 3 * M; e0 += G * NT) { const int e = e0 + tid; if (e < 3 * M) SSQ[M + e] = 0.f; }
            }
        }
        if (l == 0) { grid.sync(); xbar = xcd_barrier_post(barw, MISC); } else xcd_barrier(xbar);
#ifndef NO_P1
        { pg8::Gemm g{XN, WinT, M, LDP, DM}; pg8::StaticOrder S; S.init(M, LDP, G, bx); pg8::EpiBf16<0> E{PROJ, LDP, SSQ + (size_t)(2 * l) * M};
          pg8::gemm_phase<pg8::EpiBf16<0>, pg8::StaticOrder, true, true>(lds, g, S, E); }
#endif
        xcd_barrier(xbar);
#ifndef NO_ATTN
#pragma unroll 1
        for (int it = bx; it < 512; it += G) attn_item(lds, it, PROJ, MIX, qng, kng, sinks, cx, it, tid, lane, wid);
#endif
#ifndef NO_GLAL
        {
#pragma unroll 1
            for (int g = bx; g < 256; g += G) { float gwr[16]; const int hh = g & 3;
#pragma unroll
                for (int r = 0; r < 16; ++r) gwr[r] = ggw[r * 512 + hh * 128 + (tid & 127)];
                gla_local_group(lds, g, PROJ, KVS, DEC, gwr, ggb[hh * 128 + (tid & 127)], cx, 512 + 2 * g, tid, lane, wid); }
        }
#endif
        xcd_barrier(xbar);
#pragma unroll 1
        for (int e = bx * NT + tid; e < 131072; e += G * NT) {
            const int bh = e >> 14, rem = (e & 16383) * 2, dk = rem & 127;
            unsigned* p = (unsigned*)(KVS + (size_t)bh * 32 * 32768 + rem); const pg8::f32x2_t* d = (const pg8::f32x2_t*)(DEC + (size_t)bh * 32 * 128 + dk);
            float s0 = 0.f, s1 = 0.f; unsigned ub[2][16]; pg8::f32x2_t db[2][16];
#pragma unroll
            for (int nb = 0; nb < 2; ++nb)
#pragma unroll
                for (int i = 0; i < 16; ++i) { ub[nb][i] = p[(size_t)(nb * 16 + i) * 16384]; db[nb][i] = d[(nb * 16 + i) * 64]; }
#pragma unroll
            for (int nb = 0; nb < 2; ++nb)
#pragma unroll
                for (int i = 0; i < 16; ++i) { const unsigned u = ub[nb][i]; const pg8::f32x2_t dd = db[nb][i]; p[(size_t)(nb * 16 + i) * 16384] = pk(s0, s1); s0 = s0 * dd.x + bflo(u); s1 = s1 * dd.y + bfhi(u); }
        }
        xcd_barrier(xbar);
#ifndef NO_GLAO
#pragma unroll 1
        for (int g = bx; g < 256; g += G) gla_out_group(lds, g, PROJ, KVS, MIX, ggw, ggb, gng, tid, lane, wid);
#endif
        xcd_barrier(xbar);
#ifndef NO_P3
        { pg8::Gemm g{MIX, WoutT, M, DM, DM}; pg8::StaticOrder S; S.init(M, DM, G, bx); pg8::EpiRes<true> E{xsrc, X, DM, n2g, XN, SSQ + (size_t)(2 * l + 1) * M};
          pg8::gemm_phase<pg8::EpiRes<true>, pg8::StaticOrder, true, true>(lds, g, S, E); }
#endif
        xcd_barrier(xbar);
#ifndef NO_P4
        { pg8::Gemm g{XN, WupT, M, DFF, DM}; pg8::StaticOrder S; S.init(M, DFF, G, bx); pg8::EpiBf16<2> E{U, DFF, SSQ + (size_t)(2 * l + 1) * M};
          pg8::gemm_phase<pg8::EpiBf16<2>, pg8::StaticOrder, true, true>(lds, g, S, E); }
#endif
        xcd_barrier(xbar);
#ifndef NO_P5
        { pg8::Gemm g{U, WdnT, M, DM, DFF}; pg8::StaticOrder S; S.init(M, DM, G, bx);
          if (l + 1 < DEPTH) { pg8::EpiRes<true> E{X, X, DM, n1g + DM, XN, SSQ + (size_t)(2 * l + 2) * M}; pg8::gemm_phase<pg8::EpiRes<true>, pg8::StaticOrder, true, true>(lds, g, S, E); }
          else { pg8::EpiRes<false> E{X, X, DM, nullptr, nullptr, nullptr}; pg8::gemm_phase<pg8::EpiRes<false>, pg8::StaticOrder, true, true>(lds, g, S, E); } }
#endif
        if (l + 1 < DEPTH) xcd_barrier(xbar);
    }
}

extern "C" void kernel_launch(void* const* d_in, const int* in_sizes, int n_in, void* d_out, int out_size, void* d_ws, size_t ws_size, hipStream_t stream) {
    static int grid = 0;
    if (grid == 0) {
        if (n_in != 13 || out_size != M * DM || ws_size < WS_END) { fprintf(stderr, "kernel_launch: unexpected shapes (n_in %d out %d ws %zu)\n", n_in, out_size, ws_size); grid = -1; return; }
        int dev = 0, cus = 0, per_cu = 0;
        (void)hipGetDevice(&dev); (void)hipDeviceGetAttribute(&cus, hipDeviceAttributeMultiprocessorCount, dev);
        (void)hipFuncSetAttribute((const void*)hybrid_fwd, hipFuncAttributeMaxDynamicSharedMemorySize, LDS_BYTES);
        if (hipOccupancyMaxActiveBlocksPerMultiprocessor(&per_cu, (const void*)hybrid_fwd, NT, LDS_BYTES) != hipSuccess || per_cu < 1) per_cu = 1;
        (void)hipGetLastError();
        grid = cus * per_cu;
    }
    if (grid < 0) return;
    Args a{};
    for (int i = 0; i < 13; ++i) a.in[i] = (const float*)d_in[i];
    a.out = (float*)d_out; a.ws = (unsigned char*)d_ws;
    void* kargs[] = {&a};
    hipError_t e = hipLaunchCooperativeKernel((const void*)hybrid_fwd, dim3(grid), dim3(NT), kargs, LDS_BYTES, stream);
    if (e != hipSuccess) fprintf(stderr, "cooperative launch failed: %s (grid %d)\n", hipGetErrorString(e), grid);
}
```

```cpp
#include <hip/hip_runtime.h>
#include <hip/hip_cooperative_groups.h>
#include <cstdio>
#include <cstdint>
namespace cg = cooperative_groups;
namespace pg8 {
#define PG8_LAS __attribute__((address_space(3)))
typedef unsigned short bf16_t;
typedef short bf16x8 __attribute__((ext_vector_type(8)));
typedef float f32x4 __attribute__((ext_vector_type(4)));
typedef unsigned u32x4 __attribute__((ext_vector_type(4)));
constexpr int BM = 256, BK = 64, HALF = 128, HTB = HALF * BK * 2  , STAGE_BYTES = 8 * HTB, NXCD = 8, WGM = 8;

__host__ __device__ __forceinline__ int lds_byte(int r, int c) { const int st = (r >> 4) * 2 + (c >> 5), rr = r & 15, cc = c & 31, ob = rr * 64 + cc * 2; return st * 1024 + (ob ^ (((ob >> 9) & 1) << 5)); }
__host__ __device__ __forceinline__ void stage_rc(int b, int& R, int& C) { const int st = b / 1024, sb = b % 1024, swz = sb ^ (((sb >> 9) & 1) << 5); R = (st >> 1) * 16 + swz / 64; C = (st & 1) * 32 + (swz % 64) / 2; }
__host__ __device__ __forceinline__ int perm32(int rho) { const int n = rho >> 4, i = rho & 15; return 8 * (i >> 2) + 4 * n + (i & 3); }

struct Unit { int pm, pn; };
struct Gemm { const bf16_t* A; const bf16_t* Bt; int M, N, K; };

struct StaticOrder {
    int nM, nN, nwg, G, c;
    __host__ __device__ void init(int M, int N, int G_, int c_) { nM = M / BM; nN = N / BM; nwg = nM * nN; G = G_; c = c_; }
    __host__ __device__ bool next(int i, Unit& u) const {
        const long L = (long)i * G + c; if (L >= nwg) return false;
        int wgid = (int)L; { const int q = nwg / NXCD, r = nwg % NXCD, xcd = wgid % NXCD, off = wgid / NXCD; wgid = (xcd < r ? xcd * (q + 1) : r * (q + 1) + (xcd - r) * q) + off; }
        const int nig = WGM * nN, gid = wgid / nig, fm = gid * WGM, gsz = (nM - fm) < WGM ? (nM - fm) : WGM;
        u.pm = fm + ((wgid % nig) % gsz); u.pn = (wgid % nig) / gsz; return true;
    }
    __device__ __forceinline__ void a_ready(const Unit&) const {}
    __device__ __forceinline__ void done(const Unit&) const {}
};
typedef float f32x2_t __attribute__((ext_vector_type(2))); typedef __bf16 bf16x2_t __attribute__((ext_vector_type(2)));
__device__ __forceinline__ unsigned cvt_pk_bf16(float lo, float hi) { f32x2_t v = {lo, hi}; bf16x2_t b = __builtin_convertvector(v, bf16x2_t); return __builtin_bit_cast(unsigned, b); }
template <int ACT  > struct EpiBf16 {
    static constexpr bool PERM = true, AFTER_DRAIN = false;
    bf16_t* O; int ldc; const float* SSQ;
    __device__ __forceinline__ void operator()(const f32x4 (&acc)[2][2][4][2], const Unit& u, int wr, int wc, int fr, int fq) const {
        const int row0 = u.pm * BM + wr * 64 + fr; const int col0 = u.pn * BM + wc * 32 + 8 * fq;
        float rsv[2][4];
#pragma unroll
        for (int ai = 0; ai < 2; ++ai)
#pragma unroll
            for (int m = 0; m < 4; ++m) rsv[ai][m] = SSQ[row0 + ai * HALF + m * 16];
#pragma unroll
        for (int ai = 0; ai < 2; ++ai)
#pragma unroll
            for (int m = 0; m < 4; ++m) { const int row = row0 + ai * HALF + m * 16; bf16_t* rowp = O + (size_t)row * ldc + col0;
                const float rs = rsqrtf(rsv[ai][m] * (1.0f / 2048.0f) + 1e-6f);
#pragma unroll
                for (int bj = 0; bj < 2; ++bj) { f32x4 v0 = acc[ai][bj][m][0] * rs, v1 = acc[ai][bj][m][1] * rs;
                    if (ACT == 2) { const f32x4 z = {0.f, 0.f, 0.f, 0.f}; v0 = __builtin_elementwise_max(v0, z); v1 = __builtin_elementwise_max(v1, z); v0 = v0 * v0; v1 = v1 * v1; }
                    u32x4 w; w.x = cvt_pk_bf16(v0[0], v0[1]); w.y = cvt_pk_bf16(v0[2], v0[3]); w.z = cvt_pk_bf16(v1[0], v1[1]); w.w = cvt_pk_bf16(v1[2], v1[3]);
                    *(u32x4*)(rowp + bj * HALF) = w; } }
    }
};
template <bool NORM> struct EpiRes {
    static constexpr bool PERM = true, AFTER_DRAIN = false;
    const float* base; float* out; int ldc; const float* g; bf16_t* XG; float* SSQ;
    __device__ __forceinline__ void operator()(const f32x4 (&acc)[2][2][4][2], const Unit& u, int wr, int wc, int fr, int fq) const {
        const int col0 = u.pn * BM + wc * 32 + 8 * fq;
        f32x4 gv[2][2];
        if (NORM) {
#pragma unroll
            for (int bj = 0; bj < 2; ++bj)
#pragma unroll
                for (int n = 0; n < 2; ++n) gv[bj][n] = *(const f32x4*)(g + col0 + bj * HALF + 4 * n); }
#pragma unroll
        for (int ai = 0; ai < 2; ++ai)
#pragma unroll
        for (int mh = 0; mh < 2; ++mh) {
            f32x4 bs[2][2][2];
#pragma unroll
            for (int m2 = 0; m2 < 2; ++m2) { const size_t off = (size_t)(u.pm * BM + ai * HALF + wr * 64 + (2 * mh + m2) * 16 + fr) * ldc + col0;
#pragma unroll
                for (int bj = 0; bj < 2; ++bj)
#pragma unroll
                    for (int n = 0; n < 2; ++n) bs[m2][bj][n] = *(const f32x4*)(base + off + bj * HALF + 4 * n); }
#pragma unroll
            for (int m2 = 0; m2 < 2; ++m2) { const int m = 2 * mh + m2; const int row = u.pm * BM + ai * HALF + wr * 64 + m * 16 + fr; const size_t off = (size_t)row * ldc + col0;
                float ss = 0.f;
#pragma unroll
                for (int bj = 0; bj < 2; ++bj) { const f32x4 v0 = bs[m2][bj][0] + acc[ai][bj][m][0], v1 = bs[m2][bj][1] + acc[ai][bj][m][1];
                    *(f32x4*)(out + off + bj * HALF) = v0; *(f32x4*)(out + off + bj * HALF + 4) = v1;
                    if (NORM) { ss += (v0[0] * v0[0] + v0[1] * v0[1]) + (v0[2] * v0[2] + v0[3] * v0[3]) + (v1[0] * v1[0] + v1[1] * v1[1]) + (v1[2] * v1[2] + v1[3] * v1[3]);
                        const f32x4 y0 = v0 * gv[bj][0], y1 = v1 * gv[bj][1];
                        u32x4 w; w.x = cvt_pk_bf16(y0[0], y0[1]); w.y = cvt_pk_bf16(y0[2], y0[3]); w.z = cvt_pk_bf16(y1[0], y1[1]); w.w = cvt_pk_bf16(y1[2], y1[3]);
                        *(u32x4*)(XG + off + bj * HALF) = w; } }
                if (NORM) { ss += __shfl_xor(ss, 16); ss += __shfl_xor(ss, 32); if (fq == 0) unsafeAtomicAdd(SSQ + row, ss); } }
            asm volatile("" ::: "memory"); }
    }
};
template <class Epi, class Sched, bool ALIGN_EPI = false, bool SP2 = false>
__device__ __forceinline__ void gemm_phase(PG8_LAS unsigned char* lds, const Gemm g, const Sched& S, const Epi& E) {
    int tid_ = threadIdx.x; asm volatile("" : "+v"(tid_));
    const int tid = tid_, wid = __builtin_amdgcn_readfirstlane(tid >> 6), lane = tid & 63, wr = wid >> 2, wc = wid & 3, fr = lane & 15, fq = lane >> 4;
    const int K = g.K, nt = K / BK;
    unsigned voffA[2], voffB[2];
#pragma unroll
    for (int i = 0; i < 2; ++i) { int R, C; stage_rc(tid * 16 + i * 8192, R, C); const int Rb = Epi::PERM ? ((R & ~31) + perm32(R & 31)) : R;
        voffA[i] = (unsigned)(R * K + C) * 2u; voffB[i] = (unsigned)(Rb * K + C) * 2u; }
    const size_t kstep = (size_t)(BK * 2);
    const size_t hstep = (size_t)HALF * K * 2;
    const size_t tstep = 2 * hstep;
    const unsigned ldsw = (unsigned)wid * 1024u;
    const int aoff = lds_byte(wr * 64 + fr, fq * 8), boff = lds_byte(wc * 32 + fr, fq * 8);
#define PG8_SA(b, h) (((b) * 2 + (h)) * HTB)
#define PG8_SB(b, h) ((4 + (b) * 2 + (h)) * HTB)
#define PG8_STAGE(bufoff, gbase, voff) do { _Pragma("unroll") for (int _i = 0; _i < 2; ++_i) \
        __builtin_amdgcn_global_load_lds((const unsigned*)((const char*)(gbase) + (voff)[_i]), (PG8_LAS unsigned*)(lds + (bufoff) + ldsw + _i * 8192), 16, 0, 0); } while (0)
#define PG8_LDA(dst, b, h) do { _Pragma("unroll") for (int m = 0; m < 4; ++m) _Pragma("unroll") for (int k = 0; k < 2; ++k) dst[m][k] = *(const PG8_LAS bf16x8*)(lds + PG8_SA(b, h) + aoff + m * 2048 + k * 1024); } while (0)
#define PG8_LDB(dst, b, h) do { _Pragma("unroll") for (int n = 0; n < 2; ++n) _Pragma("unroll") for (int k = 0; k < 2; ++k) dst[n][k] = *(const PG8_LAS bf16x8*)(lds + PG8_SB(b, h) + boff + n * 2048 + k * 1024); } while (0)
#define PG8_MMA(ai, bj, At, Bt) do { __builtin_amdgcn_s_setprio(1); _Pragma("unroll") for (int m = 0; m < 4; ++m) _Pragma("unroll") for (int n = 0; n < 2; ++n) _Pragma("unroll") for (int k = 0; k < 2; ++k) \
        acc[ai][bj][m][n] = __builtin_amdgcn_mfma_f32_16x16x32_bf16(Bt[n][k], At[m][k], acc[ai][bj][m][n], 0, 0, 0); __builtin_amdgcn_s_setprio(0); } while (0)
#define PG8_WAIT_V(n) asm volatile("s_waitcnt vmcnt(" #n ")" ::: "memory")
#define PG8_WAIT_L(n) asm volatile("s_waitcnt lgkmcnt(" #n ")" ::: "memory")
#define PG8_BAR __builtin_amdgcn_s_barrier()
#define PG8_SCHED __builtin_amdgcn_sched_barrier(0)
    Unit cur, nxt; int ui = 0;
    if (!S.next(0, cur)) return;
    f32x4 acc[2][2][4][2];
#pragma unroll
    for (int a = 0; a < 2; ++a)
#pragma unroll
        for (int b = 0; b < 2; ++b)
#pragma unroll
            for (int m = 0; m < 4; ++m)
#pragma unroll
                for (int n = 0; n < 2; ++n) acc[a][b][m][n] = (f32x4){0.f, 0.f, 0.f, 0.f};
    bf16x8 At[4][2], B0[2][2], B1[2][2];
    const char* cA = (const char*)g.A + (size_t)cur.pm * tstep; const char* cB = (const char*)g.Bt + (size_t)cur.pn * tstep;
    S.a_ready(cur);
    if constexpr (SP2) {
        PG8_STAGE(PG8_SB(0, 0), cB, voffB); PG8_STAGE(PG8_SB(0, 1), cB + hstep, voffB); PG8_STAGE(PG8_SA(0, 0), cA, voffA); PG8_STAGE(PG8_SA(0, 1), cA + hstep, voffA);
        if (wr == 1) PG8_BAR;
        PG8_WAIT_V(2); PG8_BAR;
        PG8_STAGE(PG8_SB(1, 0), cB + kstep, voffB); PG8_STAGE(PG8_SA(1, 0), cA + kstep, voffA); PG8_STAGE(PG8_SB(1, 1), cB + hstep + kstep, voffB);
        PG8_WAIT_V(6); PG8_BAR;
    } else {
        PG8_STAGE(PG8_SB(0, 0), cB, voffB); PG8_STAGE(PG8_SA(0, 0), cA, voffA); PG8_STAGE(PG8_SB(0, 1), cB + hstep, voffB); PG8_STAGE(PG8_SA(0, 1), cA + hstep, voffA);
        if (wr == 1) PG8_BAR;
        PG8_WAIT_V(4); PG8_BAR;
        PG8_STAGE(PG8_SB(1, 0), cB + kstep, voffB); PG8_STAGE(PG8_SA(1, 0), cA + kstep, voffA); PG8_STAGE(PG8_SB(1, 1), cB + hstep + kstep, voffB);
        PG8_WAIT_V(6); PG8_BAR;
    }
    for (;;) {
        const bool has_next = S.next(ui + 1, nxt);
        const char* nA = has_next ? (const char*)g.A + (size_t)nxt.pm * tstep : cA; const char* nB = has_next ? (const char*)g.Bt + (size_t)nxt.pn * tstep : cB;
        for (int t = 0; t < nt; t += 2) {
            const bool last = (t == nt - 2);
            const char* a1 = cA + (size_t)(t + 1) * kstep;
            const char* a2 = last ? nA : cA + (size_t)(t + 2) * kstep; const char* b2 = last ? nB : cB + (size_t)(t + 2) * kstep;
            const char* a3 = a2 + kstep; const char* b3 = b2 + kstep;
            if (last && has_next) S.a_ready(nxt);
            if constexpr (SP2) {
            PG8_LDB(B0, 0, 0); PG8_LDB(B1, 0, 1); PG8_SCHED; PG8_LDA(At, 0, 0); PG8_STAGE(PG8_SA(1, 1), a1 + hstep, voffA);
            PG8_WAIT_V(8); PG8_WAIT_L(0); PG8_BAR; PG8_MMA(0, 0, At, B0); PG8_MMA(0, 1, At, B1); PG8_BAR; PG8_SCHED;
            PG8_LDA(At, 0, 1); PG8_STAGE(PG8_SB(0, 0), b2, voffB); PG8_STAGE(PG8_SB(0, 1), b2 + hstep, voffB); PG8_STAGE(PG8_SA(0, 0), a2, voffA);
            PG8_WAIT_V(8); PG8_WAIT_L(0); PG8_BAR; PG8_MMA(1, 0, At, B0); PG8_MMA(1, 1, At, B1); PG8_BAR; PG8_SCHED;
            PG8_LDB(B0, 1, 0); PG8_LDB(B1, 1, 1); PG8_SCHED; PG8_LDA(At, 1, 0); PG8_STAGE(PG8_SA(0, 1), a2 + hstep, voffA);
            PG8_WAIT_V(8); PG8_WAIT_L(0); PG8_BAR; PG8_MMA(0, 0, At, B0); PG8_MMA(0, 1, At, B1); PG8_BAR; PG8_SCHED;
            PG8_LDA(At, 1, 1); PG8_STAGE(PG8_SB(1, 0), b3, voffB); PG8_STAGE(PG8_SB(1, 1), b3 + hstep, voffB); PG8_STAGE(PG8_SA(1, 0), a3, voffA);
            PG8_WAIT_V(8); PG8_WAIT_L(0); PG8_BAR; PG8_MMA(1, 0, At, B0); PG8_MMA(1, 1, At, B1); PG8_BAR; PG8_SCHED;
            } else {
            PG8_LDB(B0, 0, 0); PG8_SCHED; PG8_LDA(At, 0, 0); PG8_STAGE(PG8_SA(1, 1), a1 + hstep, voffA);
            PG8_WAIT_L(8); PG8_BAR; PG8_WAIT_L(0); PG8_MMA(0, 0, At, B0); PG8_BAR; PG8_SCHED;
            PG8_LDB(B1, 0, 1); PG8_STAGE(PG8_SB(0, 0), b2, voffB);
            PG8_BAR; PG8_WAIT_L(0); PG8_MMA(0, 1, At, B1); PG8_BAR;
            PG8_LDA(At, 0, 1); PG8_STAGE(PG8_SA(0, 0), a2, voffA);
            PG8_BAR; PG8_WAIT_L(0); PG8_MMA(1, 0, At, B0); PG8_BAR; PG8_SCHED;
            PG8_STAGE(PG8_SB(0, 1), b2 + hstep, voffB);
            PG8_WAIT_V(6); PG8_BAR; PG8_MMA(1, 1, At, B1); PG8_BAR;
            PG8_LDB(B0, 1, 0); PG8_SCHED; PG8_LDA(At, 1, 0); PG8_STAGE(PG8_SA(0, 1), a2 + hstep, voffA);
            PG8_WAIT_L(8); PG8_BAR; PG8_WAIT_L(0); PG8_MMA(0, 0, At, B0); PG8_BAR; PG8_SCHED;
            PG8_LDB(B1, 1, 1); PG8_STAGE(PG8_SB(1, 0), b3, voffB);
            PG8_BAR; PG8_WAIT_L(0); PG8_MMA(0, 1, At, B1); PG8_BAR;
            PG8_LDA(At, 1, 1); PG8_STAGE(PG8_SA(1, 0), a3, voffA);
            PG8_BAR; PG8_WAIT_L(0); PG8_MMA(1, 0, At, B0); PG8_BAR; PG8_SCHED;
            PG8_STAGE(PG8_SB(1, 1), b3 + hstep, voffB);
            PG8_WAIT_V(6); PG8_BAR; PG8_MMA(1, 1, At, B1); PG8_BAR;
            }
        }
        if constexpr (ALIGN_EPI) { if (wr == 0) PG8_BAR; }
        if constexpr (!Epi::AFTER_DRAIN) { E(acc, cur, wr, wc, fr, fq); S.done(cur); }
        if (!has_next) break;
#pragma unroll
        for (int a = 0; a < 2; ++a)
#pragma unroll
            for (int b = 0; b < 2; ++b)
#pragma unroll
                for (int m = 0; m < 4; ++m)
#pragma unroll
                    for (int n = 0; n < 2; ++n) acc[a][b][m][n] = (f32x4){0.f, 0.f, 0.f, 0.f};
        cur = nxt; cA = nA; cB = nB; ++ui;
        if constexpr (ALIGN_EPI) { if (wr == 1) PG8_BAR; }
    }
    PG8_WAIT_V(0);
    if constexpr (!ALIGN_EPI) { if (wr == 0) PG8_BAR; }
    PG8_BAR;
    if constexpr (Epi::AFTER_DRAIN) { E.fused(acc, cur, wr, wc, fr, fq, lds, wid, lane); S.done(cur); }
#undef PG8_SA
#undef PG8_SB
#undef PG8_STAGE
#undef PG8_LDA
#undef PG8_LDB
#undef PG8_MMA
#undef PG8_WAIT_V
#undef PG8_WAIT_L
#undef PG8_BAR
#undef PG8_SCHED
}
}
constexpr int SEQ = 8192, DM = 2048, M = 16384, DEPTH = 2, INW = 4624, LDP = 4864, DFF = 8192;
constexpr int C_AQ = 0, C_AK = 1024, C_AV = 1280, C_GQ = 1536, C_GK = 2048, C_GV = 2560, C_GR = 3584, C_GZ = 4608;
constexpr float EPS = 1e-6f;
constexpr int NWAVES = 8, NT = 512;
constexpr size_t MiB = 1u << 20;
constexpr size_t WS_WIN = 1 * MiB, WS_WOUT = 20 * MiB, WS_WUP = 28 * MiB, WS_WDN = 60 * MiB, WS_XN = 92 * MiB;
constexpr size_t WS_U = 156 * MiB, WS_PROJ = 156 * MiB, WS_MIX = 308 * MiB, WS_KVS = 412 * MiB, WS_DEC = 476 * MiB, WS_END = 477 * MiB;
static_assert(WS_PROJ + (size_t)M * LDP * 2 <= WS_MIX && WS_MIX + (size_t)M * DM * 2 <= WS_KVS && WS_U + (size_t)M * DFF * 2 <= WS_KVS, "ws map");
constexpr int LDS_BYTES = 147456;

#define LAS __attribute__((address_space(3)))
typedef unsigned short bf16;
typedef float f32x4 __attribute__((ext_vector_type(4)));
typedef float f32x16 __attribute__((ext_vector_type(16)));
typedef short bf16x8 __attribute__((ext_vector_type(8)));
typedef unsigned u32x4 __attribute__((ext_vector_type(4)));
typedef unsigned u32x2 __attribute__((ext_vector_type(2)));
#define MFMA32(a, b, c) __builtin_amdgcn_mfma_f32_32x32x16_bf16((a), (b), (c), 0, 0, 0)

__device__ __forceinline__ float bflo(unsigned u) { return __uint_as_float(u << 16); }
__device__ __forceinline__ float bfhi(unsigned u) { return __uint_as_float(u & 0xffff0000u); }
__device__ __forceinline__ unsigned pk(float lo, float hi) { return pg8::cvt_pk_bf16(lo, hi); }
__device__ __forceinline__ float wave_sum(float v) {
#pragma unroll
    for (int o = 1; o < 64; o <<= 1) v += __shfl_xor(v, o);
    return v;
}

__device__ __forceinline__ void transpose_item(const float* W, int K, int Nsrc, int Npad, bf16* WT, LAS float* scr, int item, int lane) {
    const int nblk = Npad / 128, kb = item / nblk, nb = item % nblk, k0 = 32 * kb, n0 = 128 * nb;
    const int nl = (lane & 31) * 4, kr = lane >> 5; const bool ok = (n0 + nl) < Nsrc;
    f32x4 v[16];
#pragma unroll
    for (int i = 0; i < 16; ++i) v[i] = ok ? __builtin_nontemporal_load((const f32x4*)(W + (size_t)(k0 + 2 * i + kr) * Nsrc + n0 + nl)) : (f32x4){0.f, 0.f, 0.f, 0.f};
#pragma unroll
    for (int i = 0; i < 16; ++i) { LAS float* s = scr + (2 * i + kr) * 129 + nl; s[0] = v[i].x; s[1] = v[i].y; s[2] = v[i].z; s[3] = v[i].w; }
    asm volatile("s_waitcnt lgkmcnt(0)" ::: "memory");
    const int nn = lane >> 2, kq = lane & 3;
#pragma unroll
    for (int j = 0; j < 8; ++j) { const int n = j * 16 + nn; const LAS float* s = scr + (kq * 8) * 129 + n;
        u32x4 o; o.x = pk(s[0 * 129], s[1 * 129]); o.y = pk(s[2 * 129], s[3 * 129]); o.z = pk(s[4 * 129], s[5 * 129]); o.w = pk(s[6 * 129], s[7 * 129]);
        *(u32x4*)(WT + (size_t)(n0 + n) * K + k0 + kq * 8) = o; }
    asm volatile("s_waitcnt lgkmcnt(0)" ::: "memory");
}
__device__ __forceinline__ void prep_row(const float* xrow, const float* g, bf16* orow, float* ssq, int lane) {
    const f32x4* xr = (const f32x4*)xrow + lane; f32x4 v[8]; float s = 0.f;
#pragma unroll
    for (int j = 0; j < 8; ++j) { v[j] = __builtin_nontemporal_load(xr + 64 * j); s += (v[j].x * v[j].x + v[j].y * v[j].y) + (v[j].z * v[j].z + v[j].w * v[j].w); }
    s = wave_sum(s); if (lane == 0) *ssq = s;
    u32x2* o8 = (u32x2*)orow + lane; const f32x4* gr = (const f32x4*)g + lane;
#pragma unroll
    for (int j = 0; j < 8; ++j) { const f32x4 gg = gr[64 * j]; u32x2 w; w.x = pk(v[j].x * gg.x, v[j].y * gg.y); w.y = pk(v[j].z * gg.z, v[j].w * gg.w); o8[64 * j] = w; }
}

constexpr int CONV_NQ = 2304;
struct ConvJob { const float* W; bf16* WT; int K, N; };
__device__ __forceinline__ bool conv_decode(int q, const float* w_out, const float* w_up, const float* w_dn, bf16* WoutT, bf16* WupT, bf16* WdnT, ConvJob& j, int& k0, int& n0) {
    if (q >= CONV_NQ) return false;
    if (q < 256) { j.W = w_out; j.WT = WoutT; j.K = DM; j.N = DM; k0 = (q >> 3) * 64; n0 = (q & 7) * 256; }
    else if (q < 1280) { const int r = q - 256; j.W = w_up; j.WT = WupT; j.K = DM; j.N = DFF; k0 = (r >> 5) * 64; n0 = (r & 31) * 256; }
    else { const int r = q - 1280; j.W = w_dn; j.WT = WdnT; j.K = DFF; j.N = DM; k0 = (r >> 3) * 64; n0 = (r & 7) * 256; }
    return true;
}
struct ConvCtx { const float* w_out; const float* w_up; const float* w_dn; bf16* WoutT; bf16* WupT; bf16* WdnT; };
__device__ __forceinline__ void conv_load(const ConvCtx& cx, int q, int tid, f32x4 (&v)[8]) {
    ConvJob j; int k0, n0;
    if (!conv_decode(q, cx.w_out, cx.w_up, cx.w_dn, cx.WoutT, cx.WupT, cx.WdnT, j, k0, n0)) return;
    const float* p = j.W + (size_t)(k0 + ((tid & 63) >> 3) * 8) * j.N + n0 + (tid >> 6) * 32 + (tid & 7) * 4;
#pragma unroll
    for (int r = 0; r < 8; ++r) v[r] = __builtin_nontemporal_load((const f32x4*)(p + (size_t)r * j.N));
}
__device__ __forceinline__ void conv_store(const ConvCtx& cx, int q, int tid, const f32x4 (&v)[8]) {
    ConvJob j; int k0, n0;
    if (!conv_decode(q, cx.w_out, cx.w_up, cx.w_dn, cx.WoutT, cx.WupT, cx.WdnT, j, k0, n0)) return;
    bf16* p = j.WT + (size_t)(n0 + (tid >> 6) * 32 + (tid & 7) * 4) * j.K + k0 + ((tid & 63) >> 3) * 8;
#pragma unroll
    for (int i = 0; i < 4; ++i) { u32x4 o; o.x = pk(v[0][i], v[1][i]); o.y = pk(v[2][i], v[3][i]); o.z = pk(v[4][i], v[5][i]); o.w = pk(v[6][i], v[7][i]); *(u32x4*)(p + (size_t)i * j.K) = o; }
}

__device__ __forceinline__ void attn_item(LAS unsigned char* lds, int item, const bf16* PROJ, bf16* MIX, const float* qng, const float* kng, const float* sinks, const ConvCtx& cx, int cq, int tid, int lane, int wid) {
    const int kvh = item & 3, blk = (item >> 2) & 63, b = item >> 8;
    f32x4 cv[8];
    LAS unsigned char* Ks = lds; LAS unsigned short* Vt = (LAS unsigned short*)(lds + 36864);
    const size_t tok0 = (size_t)b * SEQ + (size_t)blk * 128;
    const int g = wid >> 1, rh = wid & 1, qh = kvh * 4 + g, h = lane >> 5, c = lane & 31;
    u32x4 qq[2][4];
    { const bf16* qp = PROJ + (tok0 + rh * 64 + c) * LDP + C_AQ + qh * 64 + h * 8;
#pragma unroll
        for (int kk = 0; kk < 4; ++kk) qq[0][kk] = *(const u32x4*)(qp + 16 * kk); }
    {
        const int key = tid >> 1, hf = tid & 1; const bool ok = (blk > 0) || (key >= 128);
        u32x4 kq[4], vq[4];
        if (ok) { const bf16* p = PROJ + (tok0 + key - 128) * LDP + C_AK + kvh * 64 + hf * 32;
#pragma unroll
            for (int i = 0; i < 4; ++i) { kq[i] = *(const u32x4*)(p + 8 * i); vq[i] = *(const u32x4*)(p + 256 + 8 * i); } }
        else {
#pragma unroll
            for (int i = 0; i < 4; ++i) { kq[i] = (u32x4){0u, 0u, 0u, 0u}; vq[i] = (u32x4){0u, 0u, 0u, 0u}; } }
        conv_load(cx, cq, tid, cv);
        float kf[32]; float ss = 0.f;
#pragma unroll
        for (int i = 0; i < 4; ++i)
#pragma unroll
            for (int c = 0; c < 4; ++c) { kf[i * 8 + 2 * c] = bflo(kq[i][c]); kf[i * 8 + 2 * c + 1] = bfhi(kq[i][c]); }
#pragma unroll
        for (int i = 0; i < 32; ++i) ss += kf[i] * kf[i];
        ss += __shfl_xor(ss, 1);
        const float rstd = rsqrtf(ss * (1.f / 64.f) + EPS);
#pragma unroll
        for (int i = 0; i < 4; ++i) { u32x4 w;
#pragma unroll
            for (int c = 0; c < 4; ++c) { const int d = hf * 32 + i * 8 + 2 * c; w[c] = pk(kf[i * 8 + 2 * c] * rstd * kng[d], kf[i * 8 + 2 * c + 1] * rstd * kng[d + 1]); }
            *(LAS u32x4*)(Ks + key * 144 + hf * 64 + i * 16) = w; }
#pragma unroll
        for (int i = 0; i < 4; ++i)
#pragma unroll
            for (int c = 0; c < 4; ++c) { const int d = hf * 32 + i * 8 + 2 * c; Vt[d * 260 + key] = (unsigned short)(vq[i][c] & 0xffffu); Vt[(d + 1) * 260 + key] = (unsigned short)(vq[i][c] >> 16); }
    }
    __syncthreads();
    conv_store(cx, cq, tid, cv);
    { const bf16* qp = PROJ + (tok0 + rh * 64 + 32 + c) * LDP + C_AQ + qh * 64 + h * 8;
#pragma unroll
        for (int kk = 0; kk < 4; ++kk) qq[1][kk] = *(const u32x4*)(qp + 16 * kk); }
    const float L2E = 1.4426950408889634f;
    const float slope2 = exp2f(-0.5f * (float)(qh + 1)) * L2E, sink2 = sinks[qh] * L2E;
    const int cm = c - 4 * h;
    const float base = -slope2 * (float)cm;
#pragma unroll 1
    for (int sb = 0; sb < 2; ++sb) {
        const int i0 = rh * 64 + sb * 32, qi = i0 + c;
        float qf[32]; float ss = 0.f;
#pragma unroll
        for (int kk = 0; kk < 4; ++kk)
#pragma unroll
            for (int cc = 0; cc < 4; ++cc) { const unsigned qw = sb ? qq[1][kk][cc] : qq[0][kk][cc]; qf[kk * 8 + 2 * cc] = bflo(qw); qf[kk * 8 + 2 * cc + 1] = bfhi(qw); }
#pragma unroll
        for (int i = 0; i < 32; ++i) ss += qf[i] * qf[i];
        ss += __shfl_xor(ss, 32);
        const float rstd = rsqrtf(ss * (1.f / 64.f) + EPS) * (0.125f * L2E);
        bf16x8 qb[4];
#pragma unroll
        for (int kk = 0; kk < 4; ++kk) { u32x4 w;
#pragma unroll
            for (int cc = 0; cc < 4; ++cc) { const int d = h * 8 + 16 * kk + 2 * cc; w[cc] = pk(qf[kk * 8 + 2 * cc] * rstd * qng[d], qf[kk * 8 + 2 * cc + 1] * rstd * qng[d + 1]); }
            qb[kk] = __builtin_bit_cast(bf16x8, w); }
        f32x16 s[5];
#pragma unroll
        for (int T = 0; T < 5; ++T) {
#pragma unroll
            for (int r = 0; r < 16; ++r) s[T][r] = 0.f;
#pragma unroll
            for (int kk = 0; kk < 4; ++kk) { const bf16x8 a = *(const LAS bf16x8*)(Ks + (i0 + 32 * T + c) * 144 + (h * 8 + 16 * kk) * 2); s[T] = MFMA32(a, qb[kk], s[T]); }
        }
        float mx = -1e30f;
#pragma unroll
        for (int T = 0; T < 5; ++T) {
            const bool dead = (blk == 0) && (i0 + 32 * T < 128);
#pragma unroll
            for (int r = 0; r < 16; ++r) { const int ep = 8 * (r >> 2) + (r & 3); float x = __builtin_fmaf(slope2, (float)(32 * T + ep - 128), s[T][r]);
                if (T == 0) x = (ep > cm) ? x : -1e30f;
                if (T == 4) x = (ep <= cm) ? x : -1e30f;
                if (dead) x = -1e30f;
                s[T][r] = x; mx = fmaxf(mx, x); } }
        float mrow = mx + base; mrow = fmaxf(mrow, __shfl_xor(mrow, 32)); mrow = fmaxf(mrow, sink2);
        const float mp = mrow - base;
        float sum = 0.f;
#pragma unroll
        for (int T = 0; T < 5; ++T)
#pragma unroll
            for (int r = 0; r < 16; ++r) { const float p = __builtin_amdgcn_exp2f(s[T][r] - mp); s[T][r] = p; sum += p; }
        sum += __shfl_xor(sum, 32); sum += __builtin_amdgcn_exp2f(sink2 - mrow);
        const float inv = 1.f / sum;
        f32x16 o[2];
#pragma unroll
        for (int mt = 0; mt < 2; ++mt)
#pragma unroll
            for (int r = 0; r < 16; ++r) o[mt][r] = 0.f;
#pragma unroll
        for (int T = 0; T < 5; ++T)
#pragma unroll
            for (int u = 0; u < 2; ++u) { u32x4 w;
#pragma unroll
                for (int cc = 0; cc < 4; ++cc) w[cc] = pk(s[T][8 * u + 2 * cc], s[T][8 * u + 2 * cc + 1]);
                const bf16x8 pb = __builtin_bit_cast(bf16x8, w);
#pragma unroll
                for (int mt = 0; mt < 2; ++mt) { const LAS unsigned short* vp = Vt + (mt * 32 + c) * 260 + i0 + 32 * T + 16 * u + 4 * h;
                    const u32x2 lo = *(const LAS u32x2*)vp, hi = *(const LAS u32x2*)(vp + 8);
                    const u32x4 av = {lo.x, lo.y, hi.x, hi.y}; o[mt] = MFMA32(__builtin_bit_cast(bf16x8, av), pb, o[mt]); } }
        bf16* op = MIX + (tok0 + qi) * DM + qh * 64 + 4 * h;
#pragma unroll
        for (int mt = 0; mt < 2; ++mt)
#pragma unroll
            for (int q4 = 0; q4 < 4; ++q4) { u32x2 w; w.x = pk(o[mt][4 * q4] * inv, o[mt][4 * q4 + 1] * inv); w.y = pk(o[mt][4 * q4 + 2] * inv, o[mt][4 * q4 + 3] * inv); *(u32x2*)(op + mt * 32 + 8 * q4) = w; }
    }
    __syncthreads();
}

constexpr int GL_GZS = 33792, GL_SEG = 37888, GL_QI = 39936, GL_KI = 58368, GL_AT = 75776, GL_VT = 84992;
__device__ __forceinline__ void gla_gate(LAS unsigned char* lds, unsigned gzw, const float (&w)[16], float bias, int tid) {
    LAS float* BsT = (LAS float*)lds; LAS float* gzs = (LAS float*)(lds + GL_GZS); LAS float* seg = (LAS float*)(lds + GL_SEG);
    { const int t = tid >> 3, r2 = (tid & 7) * 2; gzs[t * 16 + r2] = bflo(gzw); gzs[t * 16 + r2 + 1] = bfhi(gzw); }
    const int j = tid & 127, tq = tid >> 7;
    __syncthreads();
    float val[16]; float run = 0.f;
#pragma unroll
    for (int i = 0; i < 16; ++i) { const LAS f32x4* zp = (const LAS f32x4*)(gzs + (tq * 16 + i) * 16); float z = bias;
#pragma unroll
        for (int v = 0; v < 4; ++v) { const f32x4 zz = zp[v]; z += zz.x * w[4 * v] + zz.y * w[4 * v + 1] + zz.z * w[4 * v + 2] + zz.w * w[4 * v + 3]; }
        const float ls = fminf(z, 0.f) - __logf(1.f + __expf(-fabsf(z))); run += ls * (1.f / 16.f); val[i] = run; }
    seg[tq * 128 + j] = run;
    __syncthreads();
    float off = 0.f;
#pragma unroll
    for (int q = 0; q < 3; ++q) if (q < tq) off += seg[q * 128 + j];
#pragma unroll
    for (int i = 0; i < 16; ++i) BsT[j * 65 + tq * 16 + i] = val[i] + off;
    __syncthreads();
}
__device__ __forceinline__ void gla_scatter_vt(LAS unsigned char* lds, const u32x4 (&vq)[4], int tid) {
    LAS unsigned short* VT = (LAS unsigned short*)(lds + GL_VT); const int t = tid & 63, cw = tid >> 6;
#pragma unroll
    for (int i = 0; i < 4; ++i)
#pragma unroll
        for (int e = 0; e < 4; ++e) { const int c = 8 * (cw + 8 * i) + 2 * e; VT[c * 72 + t] = (unsigned short)(vq[i][e] & 0xffffu); VT[(c + 1) * 72 + t] = (unsigned short)(vq[i][e] >> 16); }
}
constexpr int GL_KST = 121856;
__device__ __forceinline__ void gla_stage_kst(LAS unsigned char* lds, LAS unsigned short* KsT, const u32x4 (&kq)[2], int tid) {
    LAS float* BsT = (LAS float*)lds; LAS float* decs = (LAS float*)(lds + GL_SEG); const int t = tid & 63, cw = tid >> 6;
#pragma unroll
    for (int i = 0; i < 2; ++i)
#pragma unroll
        for (int e = 0; e < 4; ++e) { const int j = 8 * (cw + 8 * i) + 2 * e;
            const float e0 = __expf(BsT[j * 65 + 63] - BsT[j * 65 + t]), e1 = __expf(BsT[(j + 1) * 65 + 63] - BsT[(j + 1) * 65 + t]);
            const unsigned w = pk(bflo(kq[i][e]) * e0, bfhi(kq[i][e]) * e1);
            KsT[j * 72 + t] = (unsigned short)(w & 0xffffu); KsT[(j + 1) * 72 + t] = (unsigned short)(w >> 16); }
    if (tid < 128) decs[tid] = __expf(BsT[tid * 65 + 63]);
}
__device__ __forceinline__ void gla_state_update(LAS unsigned char* lds, const LAS unsigned short* KsT, const bf16x8 (&bv)[4], f32x16 (&S)[4], bool first, int h, int c) {
    const LAS float* decs = (const LAS float*)(lds + GL_SEG);
#pragma unroll
    for (int mt = 0; mt < 4; ++mt) { f32x16 acc;
#pragma unroll
        for (int r = 0; r < 16; ++r) acc[r] = 0.f;
#pragma unroll
        for (int ks = 0; ks < 4; ++ks) { const bf16x8 a = *(const LAS bf16x8*)(KsT + (mt * 32 + c) * 72 + h * 8 + 16 * ks); acc = MFMA32(a, bv[ks], acc); }
        if (first) S[mt] = acc;
        else {
#pragma unroll
            for (int q = 0; q < 4; ++q) { const f32x4 d = *(const LAS f32x4*)(decs + mt * 32 + 8 * q + 4 * h);
#pragma unroll
                for (int e = 0; e < 4; ++e) S[mt][4 * q + e] = S[mt][4 * q + e] * d[e] + acc[4 * q + e]; } }
        __builtin_amdgcn_sched_barrier(0); }
}
__device__ __forceinline__ void gla_local_group(LAS unsigned char* lds, int g, const bf16* PROJ, bf16* KVS, float* DEC, const float (&gwr)[16], float gbias, const ConvCtx& cx, int cq0, int tid, int lane, int wid) {
    const int hh = g & 3, gi = (g >> 2) & 31, b = g >> 7; const int t = tid & 63, cw = tid >> 6, h = lane >> 5, c = lane & 31;
    LAS float* BsT = (LAS float*)lds; LAS unsigned short* KsT = (LAS unsigned short*)(lds + GL_QI); LAS unsigned short* VT = (LAS unsigned short*)(lds + GL_VT);
    f32x16 S[4]; float blsum = 0.f;
#pragma unroll 1
    for (int j = 0; j < 4; ++j) {
        const size_t R0 = (size_t)b * SEQ + (size_t)(gi * 4 + j) * 64; const int cq = cq0 + j * 256;
        f32x4 cv[8];
        const unsigned gzw = *(const unsigned*)(PROJ + (R0 + (tid >> 3)) * LDP + C_GZ + (tid & 7) * 2);
        u32x4 kq[2], vq[4];
        { const bf16* rp = PROJ + (R0 + t) * LDP;
#pragma unroll
            for (int i = 0; i < 2; ++i) kq[i] = *(const u32x4*)(rp + C_GK + hh * 128 + 8 * (cw + 8 * i));
#pragma unroll
            for (int i = 0; i < 4; ++i) vq[i] = *(const u32x4*)(rp + C_GV + hh * 256 + 8 * (cw + 8 * i)); }
        conv_load(cx, cq, tid, cv);
        gla_gate(lds, gzw, gwr, gbias, tid);
        conv_store(cx, cq, tid, cv);
        gla_scatter_vt(lds, vq, tid);
        gla_stage_kst(lds, KsT, kq, tid);
        if (tid < 128) blsum += BsT[tid * 65 + 63];
        __syncthreads();
        { bf16x8 bv[4];
#pragma unroll
            for (int ks = 0; ks < 4; ++ks) bv[ks] = *(const LAS bf16x8*)(VT + (wid * 32 + c) * 72 + h * 8 + 16 * ks);
            gla_state_update(lds, KsT, bv, S, j == 0, h, c); }
        __syncthreads();
    }
    { bf16* outp = KVS + (size_t)((b * 4 + hh) * 32 + gi) * 32768 + (size_t)(wid * 32 + c) * 128 + 4 * h;
#pragma unroll
        for (int mt = 0; mt < 4; ++mt)
#pragma unroll
            for (int q = 0; q < 4; ++q) { u32x2 w; w.x = pk(S[mt][4 * q], S[mt][4 * q + 1]); w.y = pk(S[mt][4 * q + 2], S[mt][4 * q + 3]); *(u32x2*)(outp + mt * 32 + 8 * q) = w; }
        if (tid < 128) DEC[(size_t)((b * 4 + hh) * 32 + gi) * 128 + tid] = __expf(blsum); }
}
__device__ __forceinline__ void gla_out_group(LAS unsigned char* lds, int g, const bf16* PROJ, const bf16* KVS, bf16* MIX, const float* ggw, const float* ggb, const float* gng, const ConvCtx& cx, int cq0, int tid_in, int lane_in, int wid) {
    const int hh = g & 3, gi = (g >> 2) & 31, b = g >> 7;
    LAS float* BsT = (LAS float*)lds; LAS unsigned short* Qi = (LAS unsigned short*)(lds + GL_QI); LAS unsigned short* Ki = (LAS unsigned short*)(lds + GL_KI);
    LAS unsigned short* At = (LAS unsigned short*)(lds + GL_AT); LAS unsigned short* VT = (LAS unsigned short*)(lds + GL_VT); LAS float* Ob = (LAS float*)lds;
    LAS unsigned short* KsT = (LAS unsigned short*)(lds + GL_KST);
    f32x16 S[4];
    { const int h = lane_in >> 5, c = lane_in & 31; const bf16* sp = KVS + (size_t)((b * 4 + hh) * 32 + gi) * 32768 + (size_t)(wid * 32 + c) * 128 + 4 * h;
#pragma unroll
        for (int mt = 0; mt < 4; ++mt)
#pragma unroll
            for (int q = 0; q < 4; ++q) { const u32x2 u = *(const u32x2*)(sp + mt * 32 + 8 * q); S[mt][4 * q] = bflo(u.x); S[mt][4 * q + 1] = bfhi(u.x); S[mt][4 * q + 2] = bflo(u.y); S[mt][4 * q + 3] = bfhi(u.y); } }
#pragma unroll 1
    for (int j = 0; j < 4; ++j) {
        int tid = tid_in; asm volatile("" : "+v"(tid));
        const int lane = tid & 63, t = tid & 63, cw = tid >> 6, h = lane >> 5, c = lane & 31;
        const size_t R0 = (size_t)b * SEQ + (size_t)(gi * 4 + j) * 64;
        const unsigned gzw = *(const unsigned*)(PROJ + (R0 + (tid >> 3)) * LDP + C_GZ + (tid & 7) * 2);
        u32x4 qq[2], kq[2], vq[4]; u32x2 grv[8];
        { const bf16* rp = PROJ + (R0 + t) * LDP;
#pragma unroll
            for (int i = 0; i < 2; ++i) { qq[i] = *(const u32x4*)(rp + C_GQ + hh * 128 + 8 * (cw + 8 * i)); kq[i] = *(const u32x4*)(rp + C_GK + hh * 128 + 8 * (cw + 8 * i)); }
#pragma unroll
            for (int i = 0; i < 4; ++i) vq[i] = *(const u32x4*)(rp + C_GV + hh * 256 + 8 * (cw + 8 * i));
        }
        f32x4 cv[8]; const int cq = cq0 + j * 256; conv_load(cx, cq, tid, cv);
        { float gwr[16];
#pragma unroll
            for (int r = 0; r < 16; ++r) gwr[r] = ggw[r * 512 + hh * 128 + (tid & 127)];
            gla_gate(lds, gzw, gwr, ggb[hh * 128 + (tid & 127)], tid); }
        conv_store(cx, cq, tid, cv);
        gla_scatter_vt(lds, vq, tid);
        gla_stage_kst(lds, KsT, kq, tid);
        { const float QS = 0.08838834764831845f;
#pragma unroll
            for (int i = 0; i < 2; ++i) { const int j8 = 8 * (cw + 8 * i); u32x4 oq, ok;
#pragma unroll
                for (int e = 0; e < 4; ++e) { const float b0 = BsT[(j8 + 2 * e) * 65 + t], b1 = BsT[(j8 + 2 * e + 1) * 65 + t];
                    oq[e] = pk(bflo(qq[i][e]) * QS * __expf(b0), bfhi(qq[i][e]) * QS * __expf(b1)); ok[e] = pk(bflo(kq[i][e]) * __expf(-b0), bfhi(kq[i][e]) * __expf(-b1)); }
                *(LAS u32x4*)(Qi + t * 136 + j8) = oq; *(LAS u32x4*)(Ki + t * 136 + j8) = ok; } }
        __syncthreads();
        if (wid < 4) { const int mt = wid >> 1, nt = wid & 1; f32x16 acc;
#pragma unroll
            for (int r = 0; r < 16; ++r) acc[r] = 0.f;
#pragma unroll
            for (int ks = 0; ks < 8; ++ks) { const bf16x8 a = *(const LAS bf16x8*)(Qi + (mt * 32 + c) * 136 + h * 8 + 16 * ks), bb = *(const LAS bf16x8*)(Ki + (nt * 32 + c) * 136 + h * 8 + 16 * ks); acc = MFMA32(a, bb, acc); }
#pragma unroll
            for (int r = 0; r < 16; ++r) { const int tt = mt * 32 + 8 * (r >> 2) + 4 * h + (r & 3), ss = nt * 32 + c; At[tt * 72 + ss] = (unsigned short)((ss <= tt) ? (pk(acc[r], 0.f) & 0xffffu) : 0u); } }
        __syncthreads();
        f32x16 o[2]; bf16x8 bv[4];
#pragma unroll
        for (int mt = 0; mt < 2; ++mt)
#pragma unroll
            for (int r = 0; r < 16; ++r) o[mt][r] = 0.f;
#pragma unroll
        for (int ks = 0; ks < 4; ++ks) { bv[ks] = *(const LAS bf16x8*)(VT + (wid * 32 + c) * 72 + h * 8 + 16 * ks);
#pragma unroll
            for (int mt = 0; mt < 2; ++mt) { const bf16x8 a = *(const LAS bf16x8*)(At + (mt * 32 + c) * 72 + h * 8 + 16 * ks); o[mt] = MFMA32(a, bv[ks], o[mt]); } }
#pragma unroll
        for (int ms = 0; ms < 4; ++ms)
#pragma unroll
            for (int u = 0; u < 2; ++u) { u32x4 w;
#pragma unroll
                for (int e = 0; e < 4; ++e) w[e] = pk(S[ms][8 * u + 2 * e], S[ms][8 * u + 2 * e + 1]);
                const bf16x8 sb = __builtin_bit_cast(bf16x8, w);
#pragma unroll
                for (int mt = 0; mt < 2; ++mt) { const LAS unsigned short* qp = Qi + (mt * 32 + c) * 136 + 32 * ms + 16 * u + 4 * h;
                    const u32x2 lo = *(const LAS u32x2*)qp, hi = *(const LAS u32x2*)(qp + 8); const u32x4 av = {lo.x, lo.y, hi.x, hi.y};
                    o[mt] = MFMA32(__builtin_bit_cast(bf16x8, av), sb, o[mt]); }
                __builtin_amdgcn_sched_barrier(0); }
#pragma unroll
        for (int i = 0; i < 8; ++i) grv[i] = *(const u32x2*)(PROJ + (R0 + wid * 8 + i) * LDP + C_GR + hh * 256 + lane * 4);
        gla_state_update(lds, KsT, bv, S, false, h, c);
        __syncthreads();
#pragma unroll
        for (int mt = 0; mt < 2; ++mt)
#pragma unroll
            for (int r = 0; r < 16; ++r) Ob[(mt * 32 + 8 * (r >> 2) + 4 * h + (r & 3)) * 260 + wid * 32 + c] = o[mt][r];
        __syncthreads();
        const f32x4 g4 = *(const f32x4*)(gng + lane * 4);
#pragma unroll
        for (int i = 0; i < 8; ++i) { const int tt = wid * 8 + i; const f32x4 x = *(const LAS f32x4*)(Ob + tt * 260 + lane * 4);
            const float ss = wave_sum((x.x * x.x + x.y * x.y) + (x.z * x.z + x.w * x.w)); const float rstd = rsqrtf(ss * (1.f / 256.f) + EPS);
            const float r0 = bflo(grv[i].x), r1 = bfhi(grv[i].x), r2 = bflo(grv[i].y), r3 = bfhi(grv[i].y);
            u32x2 w; w.x = pk(x.x * rstd * g4.x * (r0 / (1.f + __expf(-r0))), x.y * rstd * g4.y * (r1 / (1.f + __expf(-r1))));
            w.y = pk(x.z * rstd * g4.z * (r2 / (1.f + __expf(-r2))), x.w * rstd * g4.w * (r3 / (1.f + __expf(-r3))));
            *(u32x2*)(MIX + (R0 + tt) * DM + 1024 + hh * 256 + lane * 4) = w; }
        __syncthreads();
    }
}
#define XB_TMO      128
#define XB_XCNT(j)  (256  + 64 * (j))
#define XB_XSUB(j)  (1280 + 64 * (j))
#define XB_XGEN(j)  (2304 + 64 * (j))
#define XB_TOP      3328
#define XB_TOPGEN   3392
#define XCD_BAR_WORDS 3456
#define XB_SPIN_CAP (1u << 18)

__device__ __forceinline__ unsigned xb_ld(unsigned* p)              { return __hip_atomic_load(p, __ATOMIC_RELAXED, __HIP_MEMORY_SCOPE_AGENT); }
__device__ __forceinline__ unsigned xb_add(unsigned* p, unsigned v) { return __hip_atomic_fetch_add(p, v, __ATOMIC_RELAXED, __HIP_MEMORY_SCOPE_AGENT); }
__device__ __forceinline__ unsigned xb_xcc_id() { return (unsigned)__builtin_amdgcn_s_getreg((3 << 11) | 20) & 0xFu; }
#define XB_SPIN(cond, bar) do { unsigned _sp = 0; while (cond) { __builtin_amdgcn_s_sleep(1); \
    if ((++_sp & 255u) == 0u) { if (xb_ld(&(bar)[XB_TMO])) break; if (_sp > XB_SPIN_CAP) { atomicAdd(&(bar)[XB_TMO], 1u); break; } } } } while (0)

struct XcdBarrier {
    unsigned* bar; unsigned x;
    volatile LAS unsigned* st;
};

__device__ __forceinline__ XcdBarrier xcd_barrier_post(unsigned* bar, volatile LAS unsigned* st) {
    XcdBarrier b; b.bar = bar; b.x = xb_xcc_id(); b.st = st;
    if (threadIdx.x == 0) (void)xb_add(&bar[XB_XCNT(b.x)], 1u);
    return b;
}
__device__ __forceinline__ void xcd_barrier_complete(unsigned* bar, unsigned x, unsigned& nloc, unsigned& nx) {
    const unsigned G = gridDim.x * gridDim.y * gridDim.z;
    unsigned sum, cnt, mine, sp = 0u;
    for (;;) {
        sum = 0u; cnt = 0u; mine = 0u;
#pragma unroll
        for (unsigned j = 0; j < 16; ++j) { const unsigned c = xb_ld(&bar[XB_XCNT(j)]); sum += c; cnt += (c > 0u) ? 1u : 0u; mine = (j == x) ? c : mine; }
        if (sum == G) break;
        __builtin_amdgcn_s_sleep(1);
        if ((++sp & 255u) == 0u) { if (xb_ld(&bar[XB_TMO])) break; if (sp > XB_SPIN_CAP) { atomicAdd(&bar[XB_TMO], 1u); break; } }
    }
    nloc = mine > 0u ? mine : 1u; nx = cnt > 0u ? cnt : 1u;
}

__device__ __forceinline__ void xcd_barrier(const XcdBarrier& b) {
    asm volatile("s_waitcnt vmcnt(0)" ::: "memory");
    __syncthreads();
    if (threadIdx.x == 0) {
        unsigned* bar = b.bar;
        __builtin_amdgcn_s_waitcnt(0);
        unsigned nloc = b.st[0], nx = b.st[1];
        if (nloc == 0u) { xcd_barrier_complete(bar, b.x, nloc, nx); b.st[0] = nloc; b.st[1] = nx; }
        const unsigned old = xb_add(&bar[XB_XSUB(b.x)], 1u);
        const unsigned gen = old / nloc;
        if (old + 1u == (gen + 1u) * nloc) {
            __builtin_amdgcn_fence(__ATOMIC_RELEASE, "agent");
            asm volatile("s_waitcnt vmcnt(0)" ::: "memory");
            const unsigned og = xb_add(&bar[XB_TOP], 1u);
            const unsigned tg = og / nx;
            if (og + 1u == (tg + 1u) * nx) xb_add(&bar[XB_TOPGEN], 1u);
            else XB_SPIN(xb_ld(&bar[XB_TOPGEN]) == tg, bar);
            __builtin_amdgcn_fence(__ATOMIC_ACQUIRE, "agent");
            xb_add(&bar[XB_XGEN(b.x)], 1u);
            asm volatile("s_waitcnt vmcnt(0)" ::: "memory");
        } else {
            XB_SPIN(xb_ld(&bar[XB_XGEN(b.x)]) == gen, bar);
            __builtin_amdgcn_fence(__ATOMIC_ACQUIRE, "agent");
            asm volatile("s_waitcnt vmcnt(0)" ::: "memory");
        }
    }
    __syncthreads();
}
constexpr size_t WS_BAR = 512 * 1024;
constexpr int MISC_OFF = LDS_BYTES - 64;
struct Args { const float* in[13]; float* out; unsigned char* ws; };
__global__ void __launch_bounds__(NT, 2) hybrid_fwd(Args args) {
    extern __shared__ __attribute__((aligned(16))) unsigned char lds_raw[];
    cg::grid_group grid = cg::this_grid();
    LAS unsigned char* lds = (LAS unsigned char*)lds_raw;
    const int tid0 = threadIdx.x, wid = __builtin_amdgcn_readfirstlane(tid0 >> 6);
    const int G = gridDim.x, bx = blockIdx.x;
    const int gw = bx * NWAVES + wid, NGW = G * NWAVES;
    unsigned char* ws = args.ws;
    const float* x_in = args.in[0];
    float* X = args.out;
    bf16* WinT = (bf16*)(ws + WS_WIN); bf16* WoutT = (bf16*)(ws + WS_WOUT); bf16* WupT = (bf16*)(ws + WS_WUP); bf16* WdnT = (bf16*)(ws + WS_WDN);
    bf16* XN = (bf16*)(ws + WS_XN); bf16* PROJ = (bf16*)(ws + WS_PROJ); bf16* MIX = (bf16*)(ws + WS_MIX); bf16* U = (bf16*)(ws + WS_U);
    volatile LAS unsigned* MISC = (volatile LAS unsigned*)(lds + MISC_OFF);
    if (tid0 < 16) MISC[tid0] = 0u;
    unsigned* barw = (unsigned*)(ws + WS_BAR);
    if (bx == 0) for (int u = tid0; u < XCD_BAR_WORDS; u += NT) barw[u] = 0u;
    __syncthreads();
    XcdBarrier xbar; xbar.bar = barw; xbar.x = 0; xbar.st = MISC;
    bf16* KVS = (bf16*)(ws + WS_KVS); float* DEC = (float*)(ws + WS_DEC); float* SSQ = (float*)ws;

#pragma unroll 1
    for (int l = 0; l < DEPTH; ++l) {
        int tid = tid0; asm volatile("" : "+v"(tid));
        const int lane = tid & 63;
        const float* n1g = args.in[1] + (size_t)l * DM;
        const float* w_in = args.in[2] + (size_t)l * DM * INW;
        const float* qng = args.in[3] + l * 64; const float* kng = args.in[4] + l * 64; const float* sinks = args.in[5] + l * 16;
        const float* ggw = args.in[6] + (size_t)l * 16 * 512; const float* ggb = args.in[7] + l * 512; const float* gng = args.in[8] + l * 256;
        const float* w_out = args.in[9] + (size_t)l * DM * DM; const float* n2g = args.in[10] + (size_t)l * DM;
        const float* w_up = args.in[11] + (size_t)l * DM * DFF; const float* w_dn = args.in[12] + (size_t)l * DFF * DM;
        const float* xsrc = (l == 0) ? x_in : X;
        const ConvCtx cx{w_out, w_up, w_dn, WoutT, WupT, WdnT};

        {
            LAS float* scr = (LAS float*)(lds + wid * 16512);
            constexpr int I_IN = (DM / 32) * (LDP / 128);
#pragma unroll 1
            for (int it = gw; it < I_IN; it += NGW) transpose_item(w_in, DM, INW, LDP, WinT, scr, it, lane);
            if (l == 0) {
#pragma unroll 1
                for (int m = gw; m < M; m += NGW) prep_row(x_in + (size_t)m * DM, n1g, XN + (size_t)m * DM, SSQ + m, lane);
#pragma unroll 1
                for (int e0 = bx * NT; e0 < 3 * M; e0 += G * NT) { const int e = e0 + tid; if (e < 3 * M) SSQ[M + e] = 0.f; }
            }
        }
        if (l == 0) { grid.sync(); xbar = xcd_barrier_post(barw, MISC); } else xcd_barrier(xbar);
#ifndef NO_P1
        { pg8::Gemm g{XN, WinT, M, LDP, DM}; pg8::StaticOrder S; S.init(M, LDP, G, bx); pg8::EpiBf16<0> E{PROJ, LDP, SSQ + (size_t)(2 * l) * M};
          pg8::gemm_phase<pg8::EpiBf16<0>, pg8::StaticOrder, true, true>(lds, g, S, E); }
#endif
        xcd_barrier(xbar);
#ifndef NO_ATTN
#pragma unroll 1
        for (int it = bx; it < 512; it += G) attn_item(lds, it, PROJ, MIX, qng, kng, sinks, cx, it, tid, lane, wid);
#endif
#ifndef NO_GLAL
        {
#pragma unroll 1
            for (int g = bx; g < 256; g += G) { float gwr[16]; const int hh = g & 3;
#pragma unroll
                for (int r = 0; r < 16; ++r) gwr[r] = ggw[r * 512 + hh * 128 + (tid & 127)];
                gla_local_group(lds, g, PROJ, KVS, DEC, gwr, ggb[hh * 128 + (tid & 127)], cx, 512 + g, tid, lane, wid); }
        }
#endif
        xcd_barrier(xbar);
#pragma unroll 1
        for (int e = bx * NT + tid; e < 131072; e += G * NT) {
            const int bh = e >> 14, rem = (e & 16383) * 2, dk = rem & 127;
            unsigned* p = (unsigned*)(KVS + (size_t)bh * 32 * 32768 + rem); const pg8::f32x2_t* d = (const pg8::f32x2_t*)(DEC + (size_t)bh * 32 * 128 + dk);
            float s0 = 0.f, s1 = 0.f; unsigned ub[2][16]; pg8::f32x2_t db[2][16];
#pragma unroll
            for (int nb = 0; nb < 2; ++nb)
#pragma unroll
                for (int i = 0; i < 16; ++i) { ub[nb][i] = p[(size_t)(nb * 16 + i) * 16384]; db[nb][i] = d[(nb * 16 + i) * 64]; }
#pragma unroll
            for (int nb = 0; nb < 2; ++nb)
#pragma unroll
                for (int i = 0; i < 16; ++i) { const unsigned u = ub[nb][i]; const pg8::f32x2_t dd = db[nb][i]; p[(size_t)(nb * 16 + i) * 16384] = pk(s0, s1); s0 = s0 * dd.x + bflo(u); s1 = s1 * dd.y + bfhi(u); }
        }
        xcd_barrier(xbar);
#ifndef NO_GLAO
#pragma unroll 1
        for (int g = bx; g < 256; g += G) gla_out_group(lds, g, PROJ, KVS, MIX, ggw, ggb, gng, cx, 1536 + g, tid, lane, wid);
#endif
        xcd_barrier(xbar);
#ifndef NO_P3
        { pg8::Gemm g{MIX, WoutT, M, DM, DM}; pg8::StaticOrder S; S.init(M, DM, G, bx); pg8::EpiRes<true> E{xsrc, X, DM, n2g, XN, SSQ + (size_t)(2 * l + 1) * M};
          pg8::gemm_phase<pg8::EpiRes<true>, pg8::StaticOrder, true, true>(lds, g, S, E); }
#endif
        xcd_barrier(xbar);
#ifndef NO_P4
        { pg8::Gemm g{XN, WupT, M, DFF, DM}; pg8::StaticOrder S; S.init(M, DFF, G, bx); pg8::EpiBf16<2> E{U, DFF, SSQ + (size_t)(2 * l + 1) * M};
          pg8::gemm_phase<pg8::EpiBf16<2>, pg8::StaticOrder, true, true>(lds, g, S, E); }
#endif
        xcd_barrier(xbar);
#ifndef NO_P5
        { pg8::Gemm g{U, WdnT, M, DM, DFF}; pg8::StaticOrder S; S.init(M, DM, G, bx);
          if (l + 1 < DEPTH) { pg8::EpiRes<true> E{X, X, DM, n1g + DM, XN, SSQ + (size_t)(2 * l + 2) * M}; pg8::gemm_phase<pg8::EpiRes<true>, pg8::StaticOrder, true, true>(lds, g, S, E); }
          else { pg8::EpiRes<false> E{X, X, DM, nullptr, nullptr, nullptr}; pg8::gemm_phase<pg8::EpiRes<false>, pg8::StaticOrder, true, true>(lds, g, S, E); } }
#endif
        if (l + 1 < DEPTH) xcd_barrier(xbar);
    }
}

extern "C" void kernel_launch(void* const* d_in, const int* in_sizes, int n_in, void* d_out, int out_size, void* d_ws, size_t ws_size, hipStream_t stream) {
    static int grid = 0;
    if (grid == 0) {
        if (n_in != 13 || out_size != M * DM || ws_size < WS_END) { fprintf(stderr, "kernel_launch: unexpected shapes (n_in %d out %d ws %zu)\n", n_in, out_size, ws_size); grid = -1; return; }
        int dev = 0, cus = 0, per_cu = 0;
        (void)hipGetDevice(&dev); (void)hipDeviceGetAttribute(&cus, hipDeviceAttributeMultiprocessorCount, dev);
        (void)hipFuncSetAttribute((const void*)hybrid_fwd, hipFuncAttributeMaxDynamicSharedMemorySize, LDS_BYTES);
        if (hipOccupancyMaxActiveBlocksPerMultiprocessor(&per_cu, (const void*)hybrid_fwd, NT, LDS_BYTES) != hipSuccess || per_cu < 1) per_cu = 1;
        (void)hipGetLastError();
        grid = cus * per_cu;
    }
    if (grid < 0) return;
    Args a{};
    for (int i = 0; i < 13; ++i) a.in[i] = (const float*)d_in[i];
    a.out = (float*)d_out; a.ws = (unsigned char*)d_ws;
    void* kargs[] = {&a};
    hipError_t e = hipLaunchCooperativeKernel((const void*)hybrid_fwd, dim3(grid), dim3(NT), kargs, LDS_BYTES, stream);
    if (e != hipSuccess) fprintf(stderr, "cooperative launch failed: %s (grid %d)\n", hipGetErrorString(e), grid);
}
```

```cpp
#include <hip/hip_runtime.h>
#include <hip/hip_cooperative_groups.h>
#include <cstdio>
#include <cstdint>
namespace cg = cooperative_groups;
namespace pg8 {
#define PG8_LAS __attribute__((address_space(3)))
typedef unsigned short bf16_t;
typedef short bf16x8 __attribute__((ext_vector_type(8)));
typedef float f32x4 __attribute__((ext_vector_type(4)));
typedef unsigned u32x4 __attribute__((ext_vector_type(4)));
constexpr int BM = 256, BK = 64, HALF = 128, HTB = HALF * BK * 2  , STAGE_BYTES = 8 * HTB, NXCD = 8, WGM = 8;

__host__ __device__ __forceinline__ int lds_byte(int r, int c) { const int st = (r >> 4) * 2 + (c >> 5), rr = r & 15, cc = c & 31, ob = rr * 64 + cc * 2; return st * 1024 + (ob ^ (((ob >> 9) & 1) << 5)); }
__host__ __device__ __forceinline__ void stage_rc(int b, int& R, int& C) { const int st = b / 1024, sb = b % 1024, swz = sb ^ (((sb >> 9) & 1) << 5); R = (st >> 1) * 16 + swz / 64; C = (st & 1) * 32 + (swz % 64) / 2; }
__host__ __device__ __forceinline__ int perm32(int rho) { const int n = rho >> 4, i = rho & 15; return 8 * (i >> 2) + 4 * n + (i & 3); }

struct Unit { int pm, pn; };
struct Gemm { const bf16_t* A; const bf16_t* Bt; int M, N, K; };

struct StaticOrder {
    int nM, nN, nwg, G, c;
    __host__ __device__ void init(int M, int N, int G_, int c_) { nM = M / BM; nN = N / BM; nwg = nM * nN; G = G_; c = c_; }
    __host__ __device__ bool next(int i, Unit& u) const {
        const long L = (long)i * G + c; if (L >= nwg) return false;
        int wgid = (int)L; { const int q = nwg / NXCD, r = nwg % NXCD, xcd = wgid % NXCD, off = wgid / NXCD; wgid = (xcd < r ? xcd * (q + 1) : r * (q + 1) + (xcd - r) * q) + off; }
        const int nig = WGM * nN, gid = wgid / nig, fm = gid * WGM, gsz = (nM - fm) < WGM ? (nM - fm) : WGM;
        u.pm = fm + ((wgid % nig) % gsz); u.pn = (wgid % nig) / gsz; return true;
    }
    __device__ __forceinline__ void a_ready(const Unit&) const {}
    __device__ __forceinline__ void done(const Unit&) const {}
};
typedef float f32x2_t __attribute__((ext_vector_type(2))); typedef __bf16 bf16x2_t __attribute__((ext_vector_type(2)));
__device__ __forceinline__ unsigned cvt_pk_bf16(float lo, float hi) { f32x2_t v = {lo, hi}; bf16x2_t b = __builtin_convertvector(v, bf16x2_t); return __builtin_bit_cast(unsigned, b); }
template <int ACT  > struct EpiBf16 {
    static constexpr bool PERM = true, AFTER_DRAIN = false;
    bf16_t* O; int ldc; const float* SSQ;
    __device__ __forceinline__ void operator()(const f32x4 (&acc)[2][2][4][2], const Unit& u, int wr, int wc, int fr, int fq) const {
        const int row0 = u.pm * BM + wr * 64 + fr; const int col0 = u.pn * BM + wc * 32 + 8 * fq;
        float rsv[2][4];
#pragma unroll
        for (int ai = 0; ai < 2; ++ai)
#pragma unroll
            for (int m = 0; m < 4; ++m) rsv[ai][m] = SSQ[row0 + ai * HALF + m * 16];
#pragma unroll
        for (int ai = 0; ai < 2; ++ai)
#pragma unroll
            for (int m = 0; m < 4; ++m) { const int row = row0 + ai * HALF + m * 16; bf16_t* rowp = O + (size_t)row * ldc + col0;
                const float rs = rsqrtf(rsv[ai][m] * (1.0f / 2048.0f) + 1e-6f);
#pragma unroll
                for (int bj = 0; bj < 2; ++bj) { f32x4 v0 = acc[ai][bj][m][0] * rs, v1 = acc[ai][bj][m][1] * rs;
                    if (ACT == 2) { const f32x4 z = {0.f, 0.f, 0.f, 0.f}; v0 = __builtin_elementwise_max(v0, z); v1 = __builtin_elementwise_max(v1, z); v0 = v0 * v0; v1 = v1 * v1; }
                    u32x4 w; w.x = cvt_pk_bf16(v0[0], v0[1]); w.y = cvt_pk_bf16(v0[2], v0[3]); w.z = cvt_pk_bf16(v1[0], v1[1]); w.w = cvt_pk_bf16(v1[2], v1[3]);
                    *(u32x4*)(rowp + bj * HALF) = w; } }
    }
};
template <bool NORM> struct EpiRes {
    static constexpr bool PERM = true, AFTER_DRAIN = false;
    const float* base; float* out; int ldc; const float* g; bf16_t* XG; float* SSQ;
    __device__ __forceinline__ void operator()(const f32x4 (&acc)[2][2][4][2], const Unit& u, int wr, int wc, int fr, int fq) const {
        const int col0 = u.pn * BM + wc * 32 + 8 * fq;
        f32x4 gv[2][2];
        if (NORM) {
#pragma unroll
            for (int bj = 0; bj < 2; ++bj)
#pragma unroll
                for (int n = 0; n < 2; ++n) gv[bj][n] = *(const f32x4*)(g + col0 + bj * HALF + 4 * n); }
#pragma unroll
        for (int ai = 0; ai < 2; ++ai)
#pragma unroll
        for (int mh = 0; mh < 2; ++mh) {
            f32x4 bs[2][2][2];
#pragma unroll
            for (int m2 = 0; m2 < 2; ++m2) { const size_t off = (size_t)(u.pm * BM + ai * HALF + wr * 64 + (2 * mh + m2) * 16 + fr) * ldc + col0;
#pragma unroll
                for (int bj = 0; bj < 2; ++bj)
#pragma unroll
                    for (int n = 0; n < 2; ++n) bs[m2][bj][n] = *(const f32x4*)(base + off + bj * HALF + 4 * n); }
#pragma unroll
            for (int m2 = 0; m2 < 2; ++m2) { const int m = 2 * mh + m2; const int row = u.pm * BM + ai * HALF + wr * 64 + m * 16 + fr; const size_t off = (size_t)row * ldc + col0;
                float ss = 0.f;
#pragma unroll
                for (int bj = 0; bj < 2; ++bj) { const f32x4 v0 = bs[m2][bj][0] + acc[ai][bj][m][0], v1 = bs[m2][bj][1] + acc[ai][bj][m][1];
                    *(f32x4*)(out + off + bj * HALF) = v0; *(f32x4*)(out + off + bj * HALF + 4) = v1;
                    if (NORM) { ss += (v0[0] * v0[0] + v0[1] * v0[1]) + (v0[2] * v0[2] + v0[3] * v0[3]) + (v1[0] * v1[0] + v1[1] * v1[1]) + (v1[2] * v1[2] + v1[3] * v1[3]);
                        const f32x4 y0 = v0 * gv[bj][0], y1 = v1 * gv[bj][1];
                        u32x4 w; w.x = cvt_pk_bf16(y0[0], y0[1]); w.y = cvt_pk_bf16(y0[2], y0[3]); w.z = cvt_pk_bf16(y1[0], y1[1]); w.w = cvt_pk_bf16(y1[2], y1[3]);
                        *(u32x4*)(XG + off + bj * HALF) = w; } }
                if (NORM) { ss += __shfl_xor(ss, 16); ss += __shfl_xor(ss, 32); if (fq == 0) unsafeAtomicAdd(SSQ + row, ss); } }
            asm volatile("" ::: "memory"); }
    }
};
template <class Epi, class Sched, bool ALIGN_EPI = false, bool SP2 = false>
__device__ __forceinline__ void gemm_phase(PG8_LAS unsigned char* lds, const Gemm g, const Sched& S, const Epi& E) {
    int tid_ = threadIdx.x; asm volatile("" : "+v"(tid_));
    const int tid = tid_, wid = __builtin_amdgcn_readfirstlane(tid >> 6), lane = tid & 63, wr = wid >> 2, wc = wid & 3, fr = lane & 15, fq = lane >> 4;
    const int K = g.K, nt = K / BK;
    unsigned voffA[2], voffB[2];
#pragma unroll
    for (int i = 0; i < 2; ++i) { int R, C; stage_rc(tid * 16 + i * 8192, R, C); const int Rb = Epi::PERM ? ((R & ~31) + perm32(R & 31)) : R;
        voffA[i] = (unsigned)(R * K + C) * 2u; voffB[i] = (unsigned)(Rb * K + C) * 2u; }
    const size_t kstep = (size_t)(BK * 2);
    const size_t hstep = (size_t)HALF * K * 2;
    const size_t tstep = 2 * hstep;
    const unsigned ldsw = (unsigned)wid * 1024u;
    const int aoff = lds_byte(wr * 64 + fr, fq * 8), boff = lds_byte(wc * 32 + fr, fq * 8);
#define PG8_SA(b, h) (((b) * 2 + (h)) * HTB)
#define PG8_SB(b, h) ((4 + (b) * 2 + (h)) * HTB)
#define PG8_STAGE(bufoff, gbase, voff) do { _Pragma("unroll") for (int _i = 0; _i < 2; ++_i) \
        __builtin_amdgcn_global_load_lds((const unsigned*)((const char*)(gbase) + (voff)[_i]), (PG8_LAS unsigned*)(lds + (bufoff) + ldsw + _i * 8192), 16, 0, 0); } while (0)
#define PG8_LDA(dst, b, h) do { _Pragma("unroll") for (int m = 0; m < 4; ++m) _Pragma("unroll") for (int k = 0; k < 2; ++k) dst[m][k] = *(const PG8_LAS bf16x8*)(lds + PG8_SA(b, h) + aoff + m * 2048 + k * 1024); } while (0)
#define PG8_LDB(dst, b, h) do { _Pragma("unroll") for (int n = 0; n < 2; ++n) _Pragma("unroll") for (int k = 0; k < 2; ++k) dst[n][k] = *(const PG8_LAS bf16x8*)(lds + PG8_SB(b, h) + boff + n * 2048 + k * 1024); } while (0)
#define PG8_MMA(ai, bj, At, Bt) do { __builtin_amdgcn_s_setprio(1); _Pragma("unroll") for (int m = 0; m < 4; ++m) _Pragma("unroll") for (int n = 0; n < 2; ++n) _Pragma("unroll") for (int k = 0; k < 2; ++k) \
        acc[ai][bj][m][n] = __builtin_amdgcn_mfma_f32_16x16x32_bf16(Bt[n][k], At[m][k], acc[ai][bj][m][n], 0, 0, 0); __builtin_amdgcn_s_setprio(0); } while (0)
#define PG8_WAIT_V(n) asm volatile("s_waitcnt vmcnt(" #n ")" ::: "memory")
#define PG8_WAIT_L(n) asm volatile("s_waitcnt lgkmcnt(" #n ")" ::: "memory")
#define PG8_BAR __builtin_amdgcn_s_barrier()
#define PG8_SCHED __builtin_amdgcn_sched_barrier(0)
    Unit cur, nxt; int ui = 0;
    if (!S.next(0, cur)) return;
    f32x4 acc[2][2][4][2];
#pragma unroll
    for (int a = 0; a < 2; ++a)
#pragma unroll
        for (int b = 0; b < 2; ++b)
#pragma unroll
            for (int m = 0; m < 4; ++m)
#pragma unroll
                for (int n = 0; n < 2; ++n) acc[a][b][m][n] = (f32x4){0.f, 0.f, 0.f, 0.f};
    bf16x8 At[4][2], B0[2][2], B1[2][2];
    const char* cA = (const char*)g.A + (size_t)cur.pm * tstep; const char* cB = (const char*)g.Bt + (size_t)cur.pn * tstep;
    S.a_ready(cur);
    if constexpr (SP2) {
        PG8_STAGE(PG8_SB(0, 0), cB, voffB); PG8_STAGE(PG8_SB(0, 1), cB + hstep, voffB); PG8_STAGE(PG8_SA(0, 0), cA, voffA); PG8_STAGE(PG8_SA(0, 1), cA + hstep, voffA);
        if (wr == 1) PG8_BAR;
        PG8_WAIT_V(2); PG8_BAR;
        PG8_STAGE(PG8_SB(1, 0), cB + kstep, voffB); PG8_STAGE(PG8_SA(1, 0), cA + kstep, voffA); PG8_STAGE(PG8_SB(1, 1), cB + hstep + kstep, voffB);
        PG8_WAIT_V(6); PG8_BAR;
    } else {
        PG8_STAGE(PG8_SB(0, 0), cB, voffB); PG8_STAGE(PG8_SA(0, 0), cA, voffA); PG8_STAGE(PG8_SB(0, 1), cB + hstep, voffB); PG8_STAGE(PG8_SA(0, 1), cA + hstep, voffA);
        if (wr == 1) PG8_BAR;
        PG8_WAIT_V(4); PG8_BAR;
        PG8_STAGE(PG8_SB(1, 0), cB + kstep, voffB); PG8_STAGE(PG8_SA(1, 0), cA + kstep, voffA); PG8_STAGE(PG8_SB(1, 1), cB + hstep + kstep, voffB);
        PG8_WAIT_V(6); PG8_BAR;
    }
    for (;;) {
        const bool has_next = S.next(ui + 1, nxt);
        const char* nA = has_next ? (const char*)g.A + (size_t)nxt.pm * tstep : cA; const char* nB = has_next ? (const char*)g.Bt + (size_t)nxt.pn * tstep : cB;
        for (int t = 0; t < nt; t += 2) {
            const bool last = (t == nt - 2);
            const char* a1 = cA + (size_t)(t + 1) * kstep;
            const char* a2 = last ? nA : cA + (size_t)(t + 2) * kstep; const char* b2 = last ? nB : cB + (size_t)(t + 2) * kstep;
            const char* a3 = a2 + kstep; const char* b3 = b2 + kstep;
            if (last && has_next) S.a_ready(nxt);
            if constexpr (SP2) {
            PG8_LDB(B0, 0, 0); PG8_LDB(B1, 0, 1); PG8_SCHED; PG8_LDA(At, 0, 0); PG8_STAGE(PG8_SA(1, 1), a1 + hstep, voffA);
            PG8_WAIT_V(8); PG8_WAIT_L(0); PG8_BAR; PG8_MMA(0, 0, At, B0); PG8_MMA(0, 1, At, B1); PG8_BAR; PG8_SCHED;
            PG8_LDA(At, 0, 1); PG8_STAGE(PG8_SB(0, 0), b2, voffB); PG8_STAGE(PG8_SB(0, 1), b2 + hstep, voffB); PG8_STAGE(PG8_SA(0, 0), a2, voffA);
            PG8_WAIT_V(8); PG8_WAIT_L(0); PG8_BAR; PG8_MMA(1, 0, At, B0); PG8_MMA(1, 1, At, B1); PG8_BAR; PG8_SCHED;
            PG8_LDB(B0, 1, 0); PG8_LDB(B1, 1, 1); PG8_SCHED; PG8_LDA(At, 1, 0); PG8_STAGE(PG8_SA(0, 1), a2 + hstep, voffA);
            PG8_WAIT_V(8); PG8_WAIT_L(0); PG8_BAR; PG8_MMA(0, 0, At, B0); PG8_MMA(0, 1, At, B1); PG8_BAR; PG8_SCHED;
            PG8_LDA(At, 1, 1); PG8_STAGE(PG8_SB(1, 0), b3, voffB); PG8_STAGE(PG8_SB(1, 1), b3 + hstep, voffB); PG8_STAGE(PG8_SA(1, 0), a3, voffA);
            PG8_WAIT_V(8); PG8_WAIT_L(0); PG8_BAR; PG8_MMA(1, 0, At, B0); PG8_MMA(1, 1, At, B1); PG8_BAR; PG8_SCHED;
            } else {
            PG8_LDB(B0, 0, 0); PG8_SCHED; PG8_LDA(At, 0, 0); PG8_STAGE(PG8_SA(1, 1), a1 + hstep, voffA);
            PG8_WAIT_L(8); PG8_BAR; PG8_WAIT_L(0); PG8_MMA(0, 0, At, B0); PG8_BAR; PG8_SCHED;
            PG8_LDB(B1, 0, 1); PG8_STAGE(PG8_SB(0, 0), b2, voffB);
            PG8_BAR; PG8_WAIT_L(0); PG8_MMA(0, 1, At, B1); PG8_BAR;
            PG8_LDA(At, 0, 1); PG8_STAGE(PG8_SA(0, 0), a2, voffA);
            PG8_BAR; PG8_WAIT_L(0); PG8_MMA(1, 0, At, B0); PG8_BAR; PG8_SCHED;
            PG8_STAGE(PG8_SB(0, 1), b2 + hstep, voffB);
            PG8_WAIT_V(6); PG8_BAR; PG8_MMA(1, 1, At, B1); PG8_BAR;
            PG8_LDB(B0, 1, 0); PG8_SCHED; PG8_LDA(At, 1, 0); PG8_STAGE(PG8_SA(0, 1), a2 + hstep, voffA);
            PG8_WAIT_L(8); PG8_BAR; PG8_WAIT_L(0); PG8_MMA(0, 0, At, B0); PG8_BAR; PG8_SCHED;
            PG8_LDB(B1, 1, 1); PG8_STAGE(PG8_SB(1, 0), b3, voffB);
            PG8_BAR; PG8_WAIT_L(0); PG8_MMA(0, 1, At, B1); PG8_BAR;
            PG8_LDA(At, 1, 1); PG8_STAGE(PG8_SA(1, 0), a3, voffA);
            PG8_BAR; PG8_WAIT_L(0); PG8_MMA(1, 0, At, B0); PG8_BAR; PG8_SCHED;
            PG8_STAGE(PG8_SB(1, 1), b3 + hstep, voffB);
            PG8_WAIT_V(6); PG8_BAR; PG8_MMA(1, 1, At, B1); PG8_BAR;
            }
        }
        if constexpr (ALIGN_EPI) { if (wr == 0) PG8_BAR; }
        if constexpr (!Epi::AFTER_DRAIN) { E(acc, cur, wr, wc, fr, fq); S.done(cur); }
        if (!has_next) break;
#pragma unroll
        for (int a = 0; a < 2; ++a)
#pragma unroll
            for (int b = 0; b < 2; ++b)
#pragma unroll
                for (int m = 0; m < 4; ++m)
#pragma unroll
                    for (int n = 0; n < 2; ++n) acc[a][b][m][n] = (f32x4){0.f, 0.f, 0.f, 0.f};
        cur = nxt; cA = nA; cB = nB; ++ui;
        if constexpr (ALIGN_EPI) { if (wr == 1) PG8_BAR; }
    }
    PG8_WAIT_V(0);
    if constexpr (!ALIGN_EPI) { if (wr == 0) PG8_BAR; }
    PG8_BAR;
    if constexpr (Epi::AFTER_DRAIN) { E.fused(acc, cur, wr, wc, fr, fq, lds, wid, lane); S.done(cur); }
#undef PG8_SA
#undef PG8_SB
#undef PG8_STAGE
#undef PG8_LDA
#undef PG8_LDB
#undef PG8_MMA
#undef PG8_WAIT_V
#undef PG8_WAIT_L
#undef PG8_BAR
#undef PG8_SCHED
}
}
constexpr int SEQ = 8192, DM = 2048, M = 16384, DEPTH = 2, INW = 4624, LDP = 4864, DFF = 8192;
constexpr int C_AQ = 0, C_AK = 1024, C_AV = 1280, C_GQ = 1536, C_GK = 2048, C_GV = 2560, C_GR = 3584, C_GZ = 4608;
constexpr float EPS = 1e-6f;
constexpr int NWAVES = 8, NT = 512;
constexpr size_t MiB = 1u << 20;
constexpr size_t WS_WIN = 1 * MiB, WS_WOUT = 20 * MiB, WS_WUP = 28 * MiB, WS_WDN = 60 * MiB, WS_XN = 92 * MiB;
constexpr size_t WS_U = 156 * MiB, WS_PROJ = 156 * MiB, WS_MIX = 308 * MiB, WS_KVS = 412 * MiB, WS_DEC = 476 * MiB, WS_END = 477 * MiB;
static_assert(WS_PROJ + (size_t)M * LDP * 2 <= WS_MIX && WS_MIX + (size_t)M * DM * 2 <= WS_KVS && WS_U + (size_t)M * DFF * 2 <= WS_KVS, "ws map");
constexpr int LDS_BYTES = 147456;

#define LAS __attribute__((address_space(3)))
typedef unsigned short bf16;
typedef float f32x4 __attribute__((ext_vector_type(4)));
typedef float f32x16 __attribute__((ext_vector_type(16)));
typedef short bf16x8 __attribute__((ext_vector_type(8)));
typedef unsigned u32x4 __attribute__((ext_vector_type(4)));
typedef unsigned u32x2 __attribute__((ext_vector_type(2)));
#define MFMA32(a, b, c) __builtin_amdgcn_mfma_f32_32x32x16_bf16((a), (b), (c), 0, 0, 0)

__device__ __forceinline__ float bflo(unsigned u) { return __uint_as_float(u << 16); }
__device__ __forceinline__ float bfhi(unsigned u) { return __uint_as_float(u & 0xffff0000u); }
__device__ __forceinline__ unsigned pk(float lo, float hi) { return pg8::cvt_pk_bf16(lo, hi); }
__device__ __forceinline__ float wave_sum(float v) {
#pragma unroll
    for (int o = 1; o < 64; o <<= 1) v += __shfl_xor(v, o);
    return v;
}

__device__ __forceinline__ void transpose_item(const float* W, int K, int Nsrc, int Npad, bf16* WT, LAS float* scr, int item, int lane) {
    const int nblk = Npad / 128, kb = item / nblk, nb = item % nblk, k0 = 32 * kb, n0 = 128 * nb;
    const int nl = (lane & 31) * 4, kr = lane >> 5; const bool ok = (n0 + nl) < Nsrc;
    f32x4 v[16];
#pragma unroll
    for (int i = 0; i < 16; ++i) v[i] = ok ? __builtin_nontemporal_load((const f32x4*)(W + (size_t)(k0 + 2 * i + kr) * Nsrc + n0 + nl)) : (f32x4){0.f, 0.f, 0.f, 0.f};
#pragma unroll
    for (int i = 0; i < 16; ++i) { LAS float* s = scr + (2 * i + kr) * 129 + nl; s[0] = v[i].x; s[1] = v[i].y; s[2] = v[i].z; s[3] = v[i].w; }
    asm volatile("s_waitcnt lgkmcnt(0)" ::: "memory");
    const int nn = lane >> 2, kq = lane & 3;
#pragma unroll
    for (int j = 0; j < 8; ++j) { const int n = j * 16 + nn; const LAS float* s = scr + (kq * 8) * 129 + n;
        u32x4 o; o.x = pk(s[0 * 129], s[1 * 129]); o.y = pk(s[2 * 129], s[3 * 129]); o.z = pk(s[4 * 129], s[5 * 129]); o.w = pk(s[6 * 129], s[7 * 129]);
        *(u32x4*)(WT + (size_t)(n0 + n) * K + k0 + kq * 8) = o; }
    asm volatile("s_waitcnt lgkmcnt(0)" ::: "memory");
}
__device__ __forceinline__ void prep_row(const float* xrow, const float* g, bf16* orow, float* ssq, int lane) {
    const f32x4* xr = (const f32x4*)xrow + lane; f32x4 v[8]; float s = 0.f;
#pragma unroll
    for (int j = 0; j < 8; ++j) { v[j] = __builtin_nontemporal_load(xr + 64 * j); s += (v[j].x * v[j].x + v[j].y * v[j].y) + (v[j].z * v[j].z + v[j].w * v[j].w); }
    s = wave_sum(s); if (lane == 0) *ssq = s;
    u32x2* o8 = (u32x2*)orow + lane; const f32x4* gr = (const f32x4*)g + lane;
#pragma unroll
    for (int j = 0; j < 8; ++j) { const f32x4 gg = gr[64 * j]; u32x2 w; w.x = pk(v[j].x * gg.x, v[j].y * gg.y); w.y = pk(v[j].z * gg.z, v[j].w * gg.w); o8[64 * j] = w; }
}

constexpr int CONV_NQ = 2304;
struct ConvJob { const float* W; bf16* WT; int K, N; };
__device__ __forceinline__ bool conv_decode(int q, const float* w_out, const float* w_up, const float* w_dn, bf16* WoutT, bf16* WupT, bf16* WdnT, ConvJob& j, int& k0, int& n0) {
    if (q >= CONV_NQ) return false;
    if (q < 256) { j.W = w_out; j.WT = WoutT; j.K = DM; j.N = DM; k0 = (q >> 3) * 64; n0 = (q & 7) * 256; }
    else if (q < 1280) { const int r = q - 256; j.W = w_up; j.WT = WupT; j.K = DM; j.N = DFF; k0 = (r >> 5) * 64; n0 = (r & 31) * 256; }
    else { const int r = q - 1280; j.W = w_dn; j.WT = WdnT; j.K = DFF; j.N = DM; k0 = (r >> 3) * 64; n0 = (r & 7) * 256; }
    return true;
}
struct ConvCtx { const float* w_out; const float* w_up; const float* w_dn; bf16* WoutT; bf16* WupT; bf16* WdnT; };
__device__ __forceinline__ void conv_load(const ConvCtx& cx, int q, int tid, f32x4 (&v)[8]) {
    ConvJob j; int k0, n0;
    if (!conv_decode(q, cx.w_out, cx.w_up, cx.w_dn, cx.WoutT, cx.WupT, cx.WdnT, j, k0, n0)) return;
    const float* p = j.W + (size_t)(k0 + ((tid & 63) >> 3) * 8) * j.N + n0 + (tid >> 6) * 32 + (tid & 7) * 4;
#pragma unroll
    for (int r = 0; r < 8; ++r) v[r] = __builtin_nontemporal_load((const f32x4*)(p + (size_t)r * j.N));
}
__device__ __forceinline__ void conv_store(const ConvCtx& cx, int q, int tid, const f32x4 (&v)[8]) {
    ConvJob j; int k0, n0;
    if (!conv_decode(q, cx.w_out, cx.w_up, cx.w_dn, cx.WoutT, cx.WupT, cx.WdnT, j, k0, n0)) return;
    bf16* p = j.WT + (size_t)(n0 + (tid >> 6) * 32 + (tid & 7) * 4) * j.K + k0 + ((tid & 63) >> 3) * 8;
#pragma unroll
    for (int i = 0; i < 4; ++i) { u32x4 o; o.x = pk(v[0][i], v[1][i]); o.y = pk(v[2][i], v[3][i]); o.z = pk(v[4][i], v[5][i]); o.w = pk(v[6][i], v[7][i]); *(u32x4*)(p + (size_t)i * j.K) = o; }
}

__device__ __forceinline__ void attn_item(LAS unsigned char* lds, int item, const bf16* PROJ, bf16* MIX, const float* qng, const float* kng, const float* sinks, const ConvCtx& cx, int cq, int tid, int lane, int wid) {
    const int kvh = item & 3, blk = (item >> 2) & 63, b = item >> 8;
    f32x4 cv[8];
    LAS unsigned char* Ks = lds; LAS unsigned short* Vt = (LAS unsigned short*)(lds + 36864);
    const size_t tok0 = (size_t)b * SEQ + (size_t)blk * 128;
    const int g = wid >> 1, rh = wid & 1, qh = kvh * 4 + g, h = lane >> 5, c = lane & 31;
    u32x4 qq[2][4];
    { const bf16* qp = PROJ + (tok0 + rh * 64 + c) * LDP + C_AQ + qh * 64 + h * 8;
#pragma unroll
        for (int kk = 0; kk < 4; ++kk) qq[0][kk] = *(const u32x4*)(qp + 16 * kk); }
    {
        const int key = tid >> 1, hf = tid & 1; const bool ok = (blk > 0) || (key >= 128);
        u32x4 kq[4], vq[4];
        if (ok) { const bf16* p = PROJ + (tok0 + key - 128) * LDP + C_AK + kvh * 64 + hf * 32;
#pragma unroll
            for (int i = 0; i < 4; ++i) { kq[i] = *(const u32x4*)(p + 8 * i); vq[i] = *(const u32x4*)(p + 256 + 8 * i); } }
        else {
#pragma unroll
            for (int i = 0; i < 4; ++i) { kq[i] = (u32x4){0u, 0u, 0u, 0u}; vq[i] = (u32x4){0u, 0u, 0u, 0u}; } }
        conv_load(cx, cq, tid, cv);
        float kf[32]; float ss = 0.f;
#pragma unroll
        for (int i = 0; i < 4; ++i)
#pragma unroll
            for (int c = 0; c < 4; ++c) { kf[i * 8 + 2 * c] = bflo(kq[i][c]); kf[i * 8 + 2 * c + 1] = bfhi(kq[i][c]); }
#pragma unroll
        for (int i = 0; i < 32; ++i) ss += kf[i] * kf[i];
        ss += __shfl_xor(ss, 1);
        const float rstd = rsqrtf(ss * (1.f / 64.f) + EPS);
#pragma unroll
        for (int i = 0; i < 4; ++i) { u32x4 w;
#pragma unroll
            for (int c = 0; c < 4; ++c) { const int d = hf * 32 + i * 8 + 2 * c; w[c] = pk(kf[i * 8 + 2 * c] * rstd * kng[d], kf[i * 8 + 2 * c + 1] * rstd * kng[d + 1]); }
            *(LAS u32x4*)(Ks + key * 144 + hf * 64 + i * 16) = w; }
#pragma unroll
        for (int i = 0; i < 4; ++i)
#pragma unroll
            for (int c = 0; c < 4; ++c) { const int d = hf * 32 + i * 8 + 2 * c; Vt[d * 260 + key] = (unsigned short)(vq[i][c] & 0xffffu); Vt[(d + 1) * 260 + key] = (unsigned short)(vq[i][c] >> 16); }
    }
    __syncthreads();
    conv_store(cx, cq, tid, cv);
    { const bf16* qp = PROJ + (tok0 + rh * 64 + 32 + c) * LDP + C_AQ + qh * 64 + h * 8;
#pragma unroll
        for (int kk = 0; kk < 4; ++kk) qq[1][kk] = *(const u32x4*)(qp + 16 * kk); }
    const float L2E = 1.4426950408889634f;
    const float slope2 = exp2f(-0.5f * (float)(qh + 1)) * L2E, sink2 = sinks[qh] * L2E;
    const int cm = c - 4 * h;
    const float base = -slope2 * (float)cm;
#pragma unroll 1
    for (int sb = 0; sb < 2; ++sb) {
        const int i0 = rh * 64 + sb * 32, qi = i0 + c;
        float qf[32]; float ss = 0.f;
#pragma unroll
        for (int kk = 0; kk < 4; ++kk)
#pragma unroll
            for (int cc = 0; cc < 4; ++cc) { const unsigned qw = sb ? qq[1][kk][cc] : qq[0][kk][cc]; qf[kk * 8 + 2 * cc] = bflo(qw); qf[kk * 8 + 2 * cc + 1] = bfhi(qw); }
#pragma unroll
        for (int i = 0; i < 32; ++i) ss += qf[i] * qf[i];
        ss += __shfl_xor(ss, 32);
        const float rstd = rsqrtf(ss * (1.f / 64.f) + EPS) * (0.125f * L2E);
        bf16x8 qb[4];
#pragma unroll
        for (int kk = 0; kk < 4; ++kk) { u32x4 w;
#pragma unroll
            for (int cc = 0; cc < 4; ++cc) { const int d = h * 8 + 16 * kk + 2 * cc; w[cc] = pk(qf[kk * 8 + 2 * cc] * rstd * qng[d], qf[kk * 8 + 2 * cc + 1] * rstd * qng[d + 1]); }
            qb[kk] = __builtin_bit_cast(bf16x8, w); }
        f32x16 s[5];
#pragma unroll
        for (int T = 0; T < 5; ++T) {
#pragma unroll
            for (int r = 0; r < 16; ++r) s[T][r] = 0.f;
#pragma unroll
            for (int kk = 0; kk < 4; ++kk) { const bf16x8 a = *(const LAS bf16x8*)(Ks + (i0 + 32 * T + c) * 144 + (h * 8 + 16 * kk) * 2); s[T] = MFMA32(a, qb[kk], s[T]); }
        }
        float mx = -1e30f;
#pragma unroll
        for (int T = 0; T < 5; ++T) {
            const bool dead = (blk == 0) && (i0 + 32 * T < 128);
#pragma unroll
            for (int r = 0; r < 16; ++r) { const int ep = 8 * (r >> 2) + (r & 3); float x = __builtin_fmaf(slope2, (float)(32 * T + ep - 128), s[T][r]);
                if (T == 0) x = (ep > cm) ? x : -1e30f;
                if (T == 4) x = (ep <= cm) ? x : -1e30f;
                if (dead) x = -1e30f;
                s[T][r] = x; mx = fmaxf(mx, x); } }
        float mrow = mx + base; mrow = fmaxf(mrow, __shfl_xor(mrow, 32)); mrow = fmaxf(mrow, sink2);
        const float mp = mrow - base;
        float sum = 0.f;
#pragma unroll
        for (int T = 0; T < 5; ++T)
#pragma unroll
            for (int r = 0; r < 16; ++r) { const float p = __builtin_amdgcn_exp2f(s[T][r] - mp); s[T][r] = p; sum += p; }
        sum += __shfl_xor(sum, 32); sum += __builtin_amdgcn_exp2f(sink2 - mrow);
        const float inv = 1.f / sum;
        f32x16 o[2];
#pragma unroll
        for (int mt = 0; mt < 2; ++mt)
#pragma unroll
            for (int r = 0; r < 16; ++r) o[mt][r] = 0.f;
#pragma unroll
        for (int T = 0; T < 5; ++T)
#pragma unroll
            for (int u = 0; u < 2; ++u) { u32x4 w;
#pragma unroll
                for (int cc = 0; cc < 4; ++cc) w[cc] = pk(s[T][8 * u + 2 * cc], s[T][8 * u + 2 * cc + 1]);
                const bf16x8 pb = __builtin_bit_cast(bf16x8, w);
#pragma unroll
                for (int mt = 0; mt < 2; ++mt) { const LAS unsigned short* vp = Vt + (mt * 32 + c) * 260 + i0 + 32 * T + 16 * u + 4 * h;
                    const u32x2 lo = *(const LAS u32x2*)vp, hi = *(const LAS u32x2*)(vp + 8);
                    const u32x4 av = {lo.x, lo.y, hi.x, hi.y}; o[mt] = MFMA32(__builtin_bit_cast(bf16x8, av), pb, o[mt]); } }
        bf16* op = MIX + (tok0 + qi) * DM + qh * 64 + 4 * h;
#pragma unroll
        for (int mt = 0; mt < 2; ++mt)
#pragma unroll
            for (int q4 = 0; q4 < 4; ++q4) { u32x2 w; w.x = pk(o[mt][4 * q4] * inv, o[mt][4 * q4 + 1] * inv); w.y = pk(o[mt][4 * q4 + 2] * inv, o[mt][4 * q4 + 3] * inv); *(u32x2*)(op + mt * 32 + 8 * q4) = w; }
    }
    __syncthreads();
}

constexpr int GL_GZS = 33792, GL_SEG = 37888, GL_QI = 39936, GL_KI = 58368, GL_AT = 75776, GL_VT = 84992;
__device__ __forceinline__ void gla_gate(LAS unsigned char* lds, unsigned gzw, const float (&w)[16], float bias, int tid) {
    LAS float* BsT = (LAS float*)lds; LAS float* gzs = (LAS float*)(lds + GL_GZS); LAS float* seg = (LAS float*)(lds + GL_SEG);
    { const int t = tid >> 3, r2 = (tid & 7) * 2; gzs[t * 16 + r2] = bflo(gzw); gzs[t * 16 + r2 + 1] = bfhi(gzw); }
    const int j = tid & 127, tq = tid >> 7;
    __syncthreads();
    float val[16]; float run = 0.f;
#pragma unroll
    for (int i = 0; i < 16; ++i) { const LAS f32x4* zp = (const LAS f32x4*)(gzs + (tq * 16 + i) * 16); float z = bias;
#pragma unroll
        for (int v = 0; v < 4; ++v) { const f32x4 zz = zp[v]; z += zz.x * w[4 * v] + zz.y * w[4 * v + 1] + zz.z * w[4 * v + 2] + zz.w * w[4 * v + 3]; }
        const float ls = fminf(z, 0.f) - __logf(1.f + __expf(-fabsf(z))); run += ls * (1.f / 16.f); val[i] = run; }
    seg[tq * 128 + j] = run;
    __syncthreads();
    float off = 0.f;
#pragma unroll
    for (int q = 0; q < 3; ++q) if (q < tq) off += seg[q * 128 + j];
#pragma unroll
    for (int i = 0; i < 16; ++i) BsT[j * 65 + tq * 16 + i] = val[i] + off;
    __syncthreads();
}
__device__ __forceinline__ void gla_scatter_vt(LAS unsigned char* lds, const u32x4 (&vq)[4], int tid) {
    LAS unsigned short* VT = (LAS unsigned short*)(lds + GL_VT); const int t = tid & 63, cw = tid >> 6;
#pragma unroll
    for (int i = 0; i < 4; ++i)
#pragma unroll
        for (int e = 0; e < 4; ++e) { const int c = 8 * (cw + 8 * i) + 2 * e; VT[c * 72 + t] = (unsigned short)(vq[i][e] & 0xffffu); VT[(c + 1) * 72 + t] = (unsigned short)(vq[i][e] >> 16); }
}
constexpr int GL_KST = 121856;
__device__ __forceinline__ void gla_stage_kst(LAS unsigned char* lds, LAS unsigned short* KsT, const u32x4 (&kq)[2], int tid) {
    LAS float* BsT = (LAS float*)lds; LAS float* decs = (LAS float*)(lds + GL_SEG); const int t = tid & 63, cw = tid >> 6;
#pragma unroll
    for (int i = 0; i < 2; ++i)
#pragma unroll
        for (int e = 0; e < 4; ++e) { const int j = 8 * (cw + 8 * i) + 2 * e;
            const float e0 = __expf(BsT[j * 65 + 63] - BsT[j * 65 + t]), e1 = __expf(BsT[(j + 1) * 65 + 63] - BsT[(j + 1) * 65 + t]);
            const unsigned w = pk(bflo(kq[i][e]) * e0, bfhi(kq[i][e]) * e1);
            KsT[j * 72 + t] = (unsigned short)(w & 0xffffu); KsT[(j + 1) * 72 + t] = (unsigned short)(w >> 16); }
    if (tid < 128) decs[tid] = __expf(BsT[tid * 65 + 63]);
}
__device__ __forceinline__ void gla_state_update(LAS unsigned char* lds, const LAS unsigned short* KsT, const bf16x8 (&bv)[4], f32x16 (&S)[4], bool first, int h, int c) {
    const LAS float* decs = (const LAS float*)(lds + GL_SEG);
#pragma unroll
    for (int mt = 0; mt < 4; ++mt) { f32x16 acc;
#pragma unroll
        for (int r = 0; r < 16; ++r) acc[r] = 0.f;
#pragma unroll
        for (int ks = 0; ks < 4; ++ks) { const bf16x8 a = *(const LAS bf16x8*)(KsT + (mt * 32 + c) * 72 + h * 8 + 16 * ks); acc = MFMA32(a, bv[ks], acc); }
        if (first) S[mt] = acc;
        else {
#pragma unroll
            for (int q = 0; q < 4; ++q) { const f32x4 d = *(const LAS f32x4*)(decs + mt * 32 + 8 * q + 4 * h);
#pragma unroll
                for (int e = 0; e < 4; ++e) S[mt][4 * q + e] = S[mt][4 * q + e] * d[e] + acc[4 * q + e]; } }
        __builtin_amdgcn_sched_barrier(0); }
}
__device__ __forceinline__ void gla_local_group(LAS unsigned char* lds, int g, const bf16* PROJ, bf16* KVS, float* DEC, const float (&gwr)[16], float gbias, const ConvCtx& cx, int cq0, int tid, int lane, int wid) {
    const int hh = g & 3, gi = (g >> 2) & 31, b = g >> 7; const int t = tid & 63, cw = tid >> 6, h = lane >> 5, c = lane & 31;
    LAS float* BsT = (LAS float*)lds; LAS unsigned short* KsT = (LAS unsigned short*)(lds + GL_QI); LAS unsigned short* VT = (LAS unsigned short*)(lds + GL_VT);
    f32x16 S[4]; float blsum = 0.f;
#pragma unroll 1
    for (int j = 0; j < 4; ++j) {
        const size_t R0 = (size_t)b * SEQ + (size_t)(gi * 4 + j) * 64; const int cq = cq0 + j * 256;
        f32x4 cv[8];
        const unsigned gzw = *(const unsigned*)(PROJ + (R0 + (tid >> 3)) * LDP + C_GZ + (tid & 7) * 2);
        u32x4 kq[2], vq[4];
        { const bf16* rp = PROJ + (R0 + t) * LDP;
#pragma unroll
            for (int i = 0; i < 2; ++i) kq[i] = *(const u32x4*)(rp + C_GK + hh * 128 + 8 * (cw + 8 * i));
#pragma unroll
            for (int i = 0; i < 4; ++i) vq[i] = *(const u32x4*)(rp + C_GV + hh * 256 + 8 * (cw + 8 * i)); }
        conv_load(cx, cq, tid, cv);
        gla_gate(lds, gzw, gwr, gbias, tid);
        conv_store(cx, cq, tid, cv);
        gla_scatter_vt(lds, vq, tid);
        gla_stage_kst(lds, KsT, kq, tid);
        if (tid < 128) blsum += BsT[tid * 65 + 63];
        __syncthreads();
        { bf16x8 bv[4];
#pragma unroll
            for (int ks = 0; ks < 4; ++ks) bv[ks] = *(const LAS bf16x8*)(VT + (wid * 32 + c) * 72 + h * 8 + 16 * ks);
            gla_state_update(lds, KsT, bv, S, j == 0, h, c); }
        __syncthreads();
    }
    { bf16* outp = KVS + (size_t)((b * 4 + hh) * 32 + gi) * 32768 + (size_t)(wid * 32 + c) * 128 + 4 * h;
#pragma unroll
        for (int mt = 0; mt < 4; ++mt)
#pragma unroll
            for (int q = 0; q < 4; ++q) { u32x2 w; w.x = pk(S[mt][4 * q], S[mt][4 * q + 1]); w.y = pk(S[mt][4 * q + 2], S[mt][4 * q + 3]); *(u32x2*)(outp + mt * 32 + 8 * q) = w; }
        if (tid < 128) DEC[(size_t)((b * 4 + hh) * 32 + gi) * 128 + tid] = __expf(blsum); }
}
__device__ __forceinline__ void gla_out_group(LAS unsigned char* lds, int g, const bf16* PROJ, const bf16* KVS, bf16* MIX, const float* ggw, const float* ggb, const float* gng, const ConvCtx& cx, int cq0, int tid_in, int lane_in, int wid) {
    const int hh = g & 3, gi = (g >> 2) & 31, b = g >> 7;
    LAS float* BsT = (LAS float*)lds; LAS unsigned short* Qi = (LAS unsigned short*)(lds + GL_QI); LAS unsigned short* Ki = (LAS unsigned short*)(lds + GL_KI);
    LAS unsigned short* At = (LAS unsigned short*)(lds + GL_AT); LAS unsigned short* VT = (LAS unsigned short*)(lds + GL_VT); LAS float* Ob = (LAS float*)lds;
    LAS unsigned short* KsT = (LAS unsigned short*)(lds + GL_KST);
    f32x16 S[4];
    { const int h = lane_in >> 5, c = lane_in & 31; const bf16* sp = KVS + (size_t)((b * 4 + hh) * 32 + gi) * 32768 + (size_t)(wid * 32 + c) * 128 + 4 * h;
#pragma unroll
        for (int mt = 0; mt < 4; ++mt)
#pragma unroll
            for (int q = 0; q < 4; ++q) { const u32x2 u = *(const u32x2*)(sp + mt * 32 + 8 * q); S[mt][4 * q] = bflo(u.x); S[mt][4 * q + 1] = bfhi(u.x); S[mt][4 * q + 2] = bflo(u.y); S[mt][4 * q + 3] = bfhi(u.y); } }
    unsigned gzw_next = *(const unsigned*)(PROJ + ((size_t)b * SEQ + (size_t)(gi * 4) * 64 + (tid_in >> 3)) * LDP + C_GZ + (tid_in & 7) * 2);
    float gwr[16];
#pragma unroll
    for (int r = 0; r < 16; ++r) gwr[r] = ggw[r * 512 + hh * 128 + (tid_in & 127)];
    const float gbias = ggb[hh * 128 + (tid_in & 127)];
#pragma unroll 1
    for (int j = 0; j < 4; ++j) {
        int tid = tid_in; asm volatile("" : "+v"(tid));
        const int lane = tid & 63, t = tid & 63, cw = tid >> 6, h = lane >> 5, c = lane & 31;
        const size_t R0 = (size_t)b * SEQ + (size_t)(gi * 4 + j) * 64;
        const unsigned gzw = gzw_next;
        if (j < 3) gzw_next = *(const unsigned*)(PROJ + (R0 + 64 + (tid >> 3)) * LDP + C_GZ + (tid & 7) * 2);
        u32x4 qq[2], kq[2], vq[4]; u32x2 grv[8];
        { const bf16* rp = PROJ + (R0 + t) * LDP;
#pragma unroll
            for (int i = 0; i < 2; ++i) { qq[i] = *(const u32x4*)(rp + C_GQ + hh * 128 + 8 * (cw + 8 * i)); kq[i] = *(const u32x4*)(rp + C_GK + hh * 128 + 8 * (cw + 8 * i)); }
#pragma unroll
            for (int i = 0; i < 4; ++i) vq[i] = *(const u32x4*)(rp + C_GV + hh * 256 + 8 * (cw + 8 * i));
        }
        f32x4 cv[8]; const int cq = cq0 + j * 256; conv_load(cx, cq, tid, cv);
        gla_gate(lds, gzw, gwr, gbias, tid);
        conv_store(cx, cq, tid, cv);
        gla_scatter_vt(lds, vq, tid);
        gla_stage_kst(lds, KsT, kq, tid);
        { const float QS = 0.08838834764831845f;
#pragma unroll
            for (int i = 0; i < 2; ++i) { const int j8 = 8 * (cw + 8 * i); u32x4 oq, ok;
#pragma unroll
                for (int e = 0; e < 4; ++e) { const float b0 = BsT[(j8 + 2 * e) * 65 + t], b1 = BsT[(j8 + 2 * e + 1) * 65 + t];
                    oq[e] = pk(bflo(qq[i][e]) * QS * __expf(b0), bfhi(qq[i][e]) * QS * __expf(b1)); ok[e] = pk(bflo(kq[i][e]) * __expf(-b0), bfhi(kq[i][e]) * __expf(-b1)); }
                *(LAS u32x4*)(Qi + t * 136 + j8) = oq; *(LAS u32x4*)(Ki + t * 136 + j8) = ok; } }
        __syncthreads();
        if (wid < 4) { const int mt = wid >> 1, nt = wid & 1; f32x16 acc;
#pragma unroll
            for (int r = 0; r < 16; ++r) acc[r] = 0.f;
#pragma unroll
            for (int ks = 0; ks < 8; ++ks) { const bf16x8 a = *(const LAS bf16x8*)(Qi + (mt * 32 + c) * 136 + h * 8 + 16 * ks), bb = *(const LAS bf16x8*)(Ki + (nt * 32 + c) * 136 + h * 8 + 16 * ks); acc = MFMA32(a, bb, acc); }
#pragma unroll
            for (int r = 0; r < 16; ++r) { const int tt = mt * 32 + 8 * (r >> 2) + 4 * h + (r & 3), ss = nt * 32 + c; At[tt * 72 + ss] = (unsigned short)((ss <= tt) ? (pk(acc[r], 0.f) & 0xffffu) : 0u); } }
        __syncthreads();
        f32x16 o[2]; bf16x8 bv[4];
#pragma unroll
        for (int mt = 0; mt < 2; ++mt)
#pragma unroll
            for (int r = 0; r < 16; ++r) o[mt][r] = 0.f;
#pragma unroll
        for (int ks = 0; ks < 4; ++ks) { bv[ks] = *(const LAS bf16x8*)(VT + (wid * 32 + c) * 72 + h * 8 + 16 * ks);
#pragma unroll
            for (int mt = 0; mt < 2; ++mt) { const bf16x8 a = *(const LAS bf16x8*)(At + (mt * 32 + c) * 72 + h * 8 + 16 * ks); o[mt] = MFMA32(a, bv[ks], o[mt]); } }
#pragma unroll
        for (int ms = 0; ms < 4; ++ms)
#pragma unroll
            for (int u = 0; u < 2; ++u) { u32x4 w;
#pragma unroll
                for (int e = 0; e < 4; ++e) w[e] = pk(S[ms][8 * u + 2 * e], S[ms][8 * u + 2 * e + 1]);
                const bf16x8 sb = __builtin_bit_cast(bf16x8, w);
#pragma unroll
                for (int mt = 0; mt < 2; ++mt) { const LAS unsigned short* qp = Qi + (mt * 32 + c) * 136 + 32 * ms + 16 * u + 4 * h;
                    const u32x2 lo = *(const LAS u32x2*)qp, hi = *(const LAS u32x2*)(qp + 8); const u32x4 av = {lo.x, lo.y, hi.x, hi.y};
                    o[mt] = MFMA32(__builtin_bit_cast(bf16x8, av), sb, o[mt]); }
                __builtin_amdgcn_sched_barrier(0); }
#pragma unroll
        for (int i = 0; i < 8; ++i) grv[i] = *(const u32x2*)(PROJ + (R0 + wid * 8 + i) * LDP + C_GR + hh * 256 + lane * 4);
        gla_state_update(lds, KsT, bv, S, false, h, c);
        __syncthreads();
#pragma unroll
        for (int mt = 0; mt < 2; ++mt)
#pragma unroll
            for (int r = 0; r < 16; ++r) Ob[(mt * 32 + 8 * (r >> 2) + 4 * h + (r & 3)) * 260 + wid * 32 + c] = o[mt][r];
        __syncthreads();
        const f32x4 g4 = *(const f32x4*)(gng + lane * 4);
#pragma unroll
        for (int i = 0; i < 8; ++i) { const int tt = wid * 8 + i; const f32x4 x = *(const LAS f32x4*)(Ob + tt * 260 + lane * 4);
            const float ss = wave_sum((x.x * x.x + x.y * x.y) + (x.z * x.z + x.w * x.w)); const float rstd = rsqrtf(ss * (1.f / 256.f) + EPS);
            const float r0 = bflo(grv[i].x), r1 = bfhi(grv[i].x), r2 = bflo(grv[i].y), r3 = bfhi(grv[i].y);
            u32x2 w; w.x = pk(x.x * rstd * g4.x * (r0 / (1.f + __expf(-r0))), x.y * rstd * g4.y * (r1 / (1.f + __expf(-r1))));
            w.y = pk(x.z * rstd * g4.z * (r2 / (1.f + __expf(-r2))), x.w * rstd * g4.w * (r3 / (1.f + __expf(-r3))));
            *(u32x2*)(MIX + (R0 + tt) * DM + 1024 + hh * 256 + lane * 4) = w; }
        __syncthreads();
    }
}
#define XB_TMO      128
#define XB_XCNT(j)  (256  + 64 * (j))
#define XB_XSUB(j)  (1280 + 64 * (j))
#define XB_XGEN(j)  (2304 + 64 * (j))
#define XB_TOP      3328
#define XB_TOPGEN   3392
#define XCD_BAR_WORDS 3456
#define XB_SPIN_CAP (1u << 18)

__device__ __forceinline__ unsigned xb_ld(unsigned* p)              { return __hip_atomic_load(p, __ATOMIC_RELAXED, __HIP_MEMORY_SCOPE_AGENT); }
__device__ __forceinline__ unsigned xb_add(unsigned* p, unsigned v) { return __hip_atomic_fetch_add(p, v, __ATOMIC_RELAXED, __HIP_MEMORY_SCOPE_AGENT); }
__device__ __forceinline__ unsigned xb_xcc_id() { return (unsigned)__builtin_amdgcn_s_getreg((3 << 11) | 20) & 0xFu; }
#define XB_SPIN(cond, bar) do { unsigned _sp = 0; while (cond) { __builtin_amdgcn_s_sleep(1); \
    if ((++_sp & 255u) == 0u) { if (xb_ld(&(bar)[XB_TMO])) break; if (_sp > XB_SPIN_CAP) { atomicAdd(&(bar)[XB_TMO], 1u); break; } } } } while (0)

struct XcdBarrier {
    unsigned* bar; unsigned x;
    volatile LAS unsigned* st;
};

__device__ __forceinline__ XcdBarrier xcd_barrier_post(unsigned* bar, volatile LAS unsigned* st) {
    XcdBarrier b; b.bar = bar; b.x = xb_xcc_id(); b.st = st;
    if (threadIdx.x == 0) (void)xb_add(&bar[XB_XCNT(b.x)], 1u);
    return b;
}
__device__ __forceinline__ void xcd_barrier_complete(unsigned* bar, unsigned x, unsigned& nloc, unsigned& nx) {
    const unsigned G = gridDim.x * gridDim.y * gridDim.z;
    unsigned sum, cnt, mine, sp = 0u;
    for (;;) {
        sum = 0u; cnt = 0u; mine = 0u;
#pragma unroll
        for (unsigned j = 0; j < 16; ++j) { const unsigned c = xb_ld(&bar[XB_XCNT(j)]); sum += c; cnt += (c > 0u) ? 1u : 0u; mine = (j == x) ? c : mine; }
        if (sum == G) break;
        __builtin_amdgcn_s_sleep(1);
        if ((++sp & 255u) == 0u) { if (xb_ld(&bar[XB_TMO])) break; if (sp > XB_SPIN_CAP) { atomicAdd(&bar[XB_TMO], 1u); break; } }
    }
    nloc = mine > 0u ? mine : 1u; nx = cnt > 0u ? cnt : 1u;
}

__device__ __forceinline__ void xcd_barrier(const XcdBarrier& b) {
    asm volatile("s_waitcnt vmcnt(0)" ::: "memory");
    __syncthreads();
    if (threadIdx.x == 0) {
        unsigned* bar = b.bar;
        __builtin_amdgcn_s_waitcnt(0);
        unsigned nloc = b.st[0], nx = b.st[1];
        if (nloc == 0u) { xcd_barrier_complete(bar, b.x, nloc, nx); b.st[0] = nloc; b.st[1] = nx; }
        const unsigned old = xb_add(&bar[XB_XSUB(b.x)], 1u);
        const unsigned gen = old / nloc;
        if (old + 1u == (gen + 1u) * nloc) {
            __builtin_amdgcn_fence(__ATOMIC_RELEASE, "agent");
            asm volatile("s_waitcnt vmcnt(0)" ::: "memory");
            const unsigned og = xb_add(&bar[XB_TOP], 1u);
            const unsigned tg = og / nx;
            if (og + 1u == (tg + 1u) * nx) xb_add(&bar[XB_TOPGEN], 1u);
            else XB_SPIN(xb_ld(&bar[XB_TOPGEN]) == tg, bar);
            __builtin_amdgcn_fence(__ATOMIC_ACQUIRE, "agent");
            xb_add(&bar[XB_XGEN(b.x)], 1u);
            asm volatile("s_waitcnt vmcnt(0)" ::: "memory");
        } else {
            XB_SPIN(xb_ld(&bar[XB_XGEN(b.x)]) == gen, bar);
            __builtin_amdgcn_fence(__ATOMIC_ACQUIRE, "agent");
            asm volatile("s_waitcnt vmcnt(0)" ::: "memory");
        }
    }
    __syncthreads();
}
constexpr size_t WS_BAR = 512 * 1024;
constexpr int MISC_OFF = LDS_BYTES - 64;
struct Args { const float* in[13]; float* out; unsigned char* ws; };
__global__ void __launch_bounds__(NT, 2) hybrid_fwd(Args args) {
    extern __shared__ __attribute__((aligned(16))) unsigned char lds_raw[];
    cg::grid_group grid = cg::this_grid();
    LAS unsigned char* lds = (LAS unsigned char*)lds_raw;
    const int tid0 = threadIdx.x, wid = __builtin_amdgcn_readfirstlane(tid0 >> 6);
    const int G = gridDim.x, bx = blockIdx.x;
    const int gw = bx * NWAVES + wid, NGW = G * NWAVES;
    unsigned char* ws = args.ws;
    const float* x_in = args.in[0];
    float* X = args.out;
    bf16* WinT = (bf16*)(ws + WS_WIN); bf16* WoutT = (bf16*)(ws + WS_WOUT); bf16* WupT = (bf16*)(ws + WS_WUP); bf16* WdnT = (bf16*)(ws + WS_WDN);
    bf16* XN = (bf16*)(ws + WS_XN); bf16* PROJ = (bf16*)(ws + WS_PROJ); bf16* MIX = (bf16*)(ws + WS_MIX); bf16* U = (bf16*)(ws + WS_U);
    volatile LAS unsigned* MISC = (volatile LAS unsigned*)(lds + MISC_OFF);
    if (tid0 < 16) MISC[tid0] = 0u;
    unsigned* barw = (unsigned*)(ws + WS_BAR);
    if (bx == 0) for (int u = tid0; u < XCD_BAR_WORDS; u += NT) barw[u] = 0u;
    __syncthreads();
    XcdBarrier xbar; xbar.bar = barw; xbar.x = 0; xbar.st = MISC;
    bf16* KVS = (bf16*)(ws + WS_KVS); float* DEC = (float*)(ws + WS_DEC); float* SSQ = (float*)ws;

#pragma unroll 1
    for (int l = 0; l < DEPTH; ++l) {
        int tid = tid0; asm volatile("" : "+v"(tid));
        const int lane = tid & 63;
        const float* n1g = args.in[1] + (size_t)l * DM;
        const float* w_in = args.in[2] + (size_t)l * DM * INW;
        const float* qng = args.in[3] + l * 64; const float* kng = args.in[4] + l * 64; const float* sinks = args.in[5] + l * 16;
        const float* ggw = args.in[6] + (size_t)l * 16 * 512; const float* ggb = args.in[7] + l * 512; const float* gng = args.in[8] + l * 256;
        const float* w_out = args.in[9] + (size_t)l * DM * DM; const float* n2g = args.in[10] + (size_t)l * DM;
        const float* w_up = args.in[11] + (size_t)l * DM * DFF; const float* w_dn = args.in[12] + (size_t)l * DFF * DM;
        const float* xsrc = (l == 0) ? x_in : X;
        const ConvCtx cx{w_out, w_up, w_dn, WoutT, WupT, WdnT};

        {
            LAS float* scr = (LAS float*)(lds + wid * 16512);
            constexpr int I_IN = (DM / 32) * (LDP / 128);
#pragma unroll 1
            for (int it = gw; it < I_IN; it += NGW) transpose_item(w_in, DM, INW, LDP, WinT, scr, it, lane);
            if (l == 0) {
#pragma unroll 1
                for (int m = gw; m < M; m += NGW) prep_row(x_in + (size_t)m * DM, n1g, XN + (size_t)m * DM, SSQ + m, lane);
#pragma unroll 1
                for (int e0 = bx * NT; e0 < 3 * M; e0 += G * NT) { const int e = e0 + tid; if (e < 3 * M) SSQ[M + e] = 0.f; }
            }
        }
        if (l == 0) { grid.sync(); xbar = xcd_barrier_post(barw, MISC); } else xcd_barrier(xbar);
#ifndef NO_P1
        { pg8::Gemm g{XN, WinT, M, LDP, DM}; pg8::StaticOrder S; S.init(M, LDP, G, bx); pg8::EpiBf16<0> E{PROJ, LDP, SSQ + (size_t)(2 * l) * M};
          pg8::gemm_phase<pg8::EpiBf16<0>, pg8::StaticOrder, true, true>(lds, g, S, E); }
#endif
        xcd_barrier(xbar);
#ifndef NO_ATTN
#pragma unroll 1
        for (int it = bx; it < 512; it += G) attn_item(lds, it, PROJ, MIX, qng, kng, sinks, cx, it, tid, lane, wid);
#endif
#ifndef NO_GLAL
        {
#pragma unroll 1
            for (int g = bx; g < 256; g += G) { float gwr[16]; const int hh = g & 3;
#pragma unroll
                for (int r = 0; r < 16; ++r) gwr[r] = ggw[r * 512 + hh * 128 + (tid & 127)];
                gla_local_group(lds, g, PROJ, KVS, DEC, gwr, ggb[hh * 128 + (tid & 127)], cx, 512 + g, tid, lane, wid); }
        }
#endif
        xcd_barrier(xbar);
#pragma unroll 1
        for (int e = bx * NT + tid; e < 131072; e += G * NT) {
            const int bh = e >> 14, rem = (e & 16383) * 2, dk = rem & 127;
            unsigned* p = (unsigned*)(KVS + (size_t)bh * 32 * 32768 + rem); const pg8::f32x2_t* d = (const pg8::f32x2_t*)(DEC + (size_t)bh * 32 * 128 + dk);
            float s0 = 0.f, s1 = 0.f; unsigned ub[2][16]; pg8::f32x2_t db[2][16];
#pragma unroll
            for (int nb = 0; nb < 2; ++nb)
#pragma unroll
                for (int i = 0; i < 16; ++i) { ub[nb][i] = p[(size_t)(nb * 16 + i) * 16384]; db[nb][i] = d[(nb * 16 + i) * 64]; }
#pragma unroll
            for (int nb = 0; nb < 2; ++nb)
#pragma unroll
                for (int i = 0; i < 16; ++i) { const unsigned u = ub[nb][i]; const pg8::f32x2_t dd = db[nb][i]; p[(size_t)(nb * 16 + i) * 16384] = pk(s0, s1); s0 = s0 * dd.x + bflo(u); s1 = s1 * dd.y + bfhi(u); }
        }
        xcd_barrier(xbar);
#ifndef NO_GLAO
#pragma unroll 1
        for (int g = bx; g < 256; g += G) gla_out_group(lds, g, PROJ, KVS, MIX, ggw, ggb, gng, cx, 1536 + g, tid, lane, wid);
#endif
        xcd_barrier(xbar);
#ifndef NO_P3
        { pg8::Gemm g{MIX, WoutT, M, DM, DM}; pg8::StaticOrder S; S.init(M, DM, G, bx); pg8::EpiRes<true> E{xsrc, X, DM, n2g, XN, SSQ + (size_t)(2 * l + 1) * M};
          pg8::gemm_phase<pg8::EpiRes<true>, pg8::StaticOrder, true, true>(lds, g, S, E); }
#endif
        xcd_barrier(xbar);
#ifndef NO_P4
        { pg8::Gemm g{XN, WupT, M, DFF, DM}; pg8::StaticOrder S; S.init(M, DFF, G, bx); pg8::EpiBf16<2> E{U, DFF, SSQ + (size_t)(2 * l + 1) * M};
          pg8::gemm_phase<pg8::EpiBf16<2>, pg8::StaticOrder, true, true>(lds, g, S, E); }
#endif
        xcd_barrier(xbar);
#ifndef NO_P5
        { pg8::Gemm g{U, WdnT, M, DM, DFF}; pg8::StaticOrder S; S.init(M, DM, G, bx);
          if (l + 1 < DEPTH) { pg8::EpiRes<true> E{X, X, DM, n1g + DM, XN, SSQ + (size_t)(2 * l + 2) * M}; pg8::gemm_phase<pg8::EpiRes<true>, pg8::StaticOrder, true, true>(lds, g, S, E); }
          else { pg8::EpiRes<false> E{X, X, DM, nullptr, nullptr, nullptr}; pg8::gemm_phase<pg8::EpiRes<false>, pg8::StaticOrder, true, true>(lds, g, S, E); } }
#endif
        if (l + 1 < DEPTH) xcd_barrier(xbar);
    }
}

extern "C" void kernel_launch(void* const* d_in, const int* in_sizes, int n_in, void* d_out, int out_size, void* d_ws, size_t ws_size, hipStream_t stream) {
    static int grid = 0;
    if (grid == 0) {
        if (n_in != 13 || out_size != M * DM || ws_size < WS_END) { fprintf(stderr, "kernel_launch: unexpected shapes (n_in %d out %d ws %zu)\n", n_in, out_size, ws_size); grid = -1; return; }
        int dev = 0, cus = 0, per_cu = 0;
        (void)hipGetDevice(&dev); (void)hipDeviceGetAttribute(&cus, hipDeviceAttributeMultiprocessorCount, dev);
        (void)hipFuncSetAttribute((const void*)hybrid_fwd, hipFuncAttributeMaxDynamicSharedMemorySize, LDS_BYTES);
        if (hipOccupancyMaxActiveBlocksPerMultiprocessor(&per_cu, (const void*)hybrid_fwd, NT, LDS_BYTES) != hipSuccess || per_cu < 1) per_cu = 1;
        (void)hipGetLastError();
        grid = cus * per_cu;
    }
    if (grid < 0) return;
    Args a{};
    for (int i = 0; i < 13; ++i) a.in[i] = (const float*)d_in[i];
    a.out = (float*)d_out; a.ws = (unsigned char*)d_ws;
    void* kargs[] = {&a};
    hipError_t e = hipLaunchCooperativeKernel((const void*)hybrid_fwd, dim3(grid), dim3(NT), kargs, LDS_BYTES, stream);
    if (e != hipSuccess) fprintf(stderr, "cooperative launch failed: %s (grid %d)\n", hipGetErrorString(e), grid);
}
```

```cpp
#include <hip/hip_runtime.h>
#include <hip/hip_cooperative_groups.h>
#include <cstdio>
#include <cstdint>
namespace cg = cooperative_groups;
namespace pg8 {
#define PG8_LAS __attribute__((address_space(3)))
typedef unsigned short bf16_t;
typedef short bf16x8 __attribute__((ext_vector_type(8)));
typedef float f32x4 __attribute__((ext_vector_type(4)));
typedef unsigned u32x4 __attribute__((ext_vector_type(4)));
constexpr int BM = 256, BK = 64, HALF = 128, HTB = HALF * BK * 2  , STAGE_BYTES = 8 * HTB, NXCD = 8, WGM = 8;

__host__ __device__ __forceinline__ int lds_byte(int r, int c) { const int st = (r >> 4) * 2 + (c >> 5), rr = r & 15, cc = c & 31, ob = rr * 64 + cc * 2; return st * 1024 + (ob ^ (((ob >> 9) & 1) << 5)); }
__host__ __device__ __forceinline__ void stage_rc(int b, int& R, int& C) { const int st = b / 1024, sb = b % 1024, swz = sb ^ (((sb >> 9) & 1) << 5); R = (st >> 1) * 16 + swz / 64; C = (st & 1) * 32 + (swz % 64) / 2; }
__host__ __device__ __forceinline__ int perm32(int rho) { const int n = rho >> 4, i = rho & 15; return 8 * (i >> 2) + 4 * n + (i & 3); }

struct Unit { int pm, pn; };
struct Gemm { const bf16_t* A; const bf16_t* Bt; int M, N, K; };

struct StaticOrder {
    int nM, nN, nwg, G, c;
    __host__ __device__ void init(int M, int N, int G_, int c_) { nM = M / BM; nN = N / BM; nwg = nM * nN; G = G_; c = c_; }
    __host__ __device__ bool next(int i, Unit& u) const {
        const long L = (long)i * G + c; if (L >= nwg) return false;
        int wgid = (int)L; { const int q = nwg / NXCD, r = nwg % NXCD, xcd = wgid % NXCD, off = wgid / NXCD; wgid = (xcd < r ? xcd * (q + 1) : r * (q + 1) + (xcd - r) * q) + off; }
        const int nig = WGM * nN, gid = wgid / nig, fm = gid * WGM, gsz = (nM - fm) < WGM ? (nM - fm) : WGM;
        u.pm = fm + ((wgid % nig) % gsz); u.pn = (wgid % nig) / gsz; return true;
    }
    __device__ __forceinline__ void a_ready(const Unit&) const {}
    __device__ __forceinline__ void done(const Unit&) const {}
};
typedef float f32x2_t __attribute__((ext_vector_type(2))); typedef __bf16 bf16x2_t __attribute__((ext_vector_type(2)));
__device__ __forceinline__ unsigned cvt_pk_bf16(float lo, float hi) { f32x2_t v = {lo, hi}; bf16x2_t b = __builtin_convertvector(v, bf16x2_t); return __builtin_bit_cast(unsigned, b); }
template <int ACT  > struct EpiBf16 {
    static constexpr bool PERM = true, AFTER_DRAIN = false;
    bf16_t* O; int ldc; const float* SSQ;
    __device__ __forceinline__ void operator()(const f32x4 (&acc)[2][2][4][2], const Unit& u, int wr, int wc, int fr, int fq) const {
        const int row0 = u.pm * BM + wr * 64 + fr; const int col0 = u.pn * BM + wc * 32 + 8 * fq;
        float rsv[2][4];
#pragma unroll
        for (int ai = 0; ai < 2; ++ai)
#pragma unroll
            for (int m = 0; m < 4; ++m) rsv[ai][m] = SSQ[row0 + ai * HALF + m * 16];
#pragma unroll
        for (int ai = 0; ai < 2; ++ai)
#pragma unroll
            for (int m = 0; m < 4; ++m) { const int row = row0 + ai * HALF + m * 16; bf16_t* rowp = O + (size_t)row * ldc + col0;
                const float rs = rsqrtf(rsv[ai][m] * (1.0f / 2048.0f) + 1e-6f);
#pragma unroll
                for (int bj = 0; bj < 2; ++bj) { f32x4 v0 = acc[ai][bj][m][0] * rs, v1 = acc[ai][bj][m][1] * rs;
                    if (ACT == 2) { const f32x4 z = {0.f, 0.f, 0.f, 0.f}; v0 = __builtin_elementwise_max(v0, z); v1 = __builtin_elementwise_max(v1, z); v0 = v0 * v0; v1 = v1 * v1; }
                    u32x4 w; w.x = cvt_pk_bf16(v0[0], v0[1]); w.y = cvt_pk_bf16(v0[2], v0[3]); w.z = cvt_pk_bf16(v1[0], v1[1]); w.w = cvt_pk_bf16(v1[2], v1[3]);
                    *(u32x4*)(rowp + bj * HALF) = w; } }
    }
};
template <bool NORM> struct EpiRes {
    static constexpr bool PERM = true, AFTER_DRAIN = false;
    const float* base; float* out; int ldc; const float* g; bf16_t* XG; float* SSQ;
    __device__ __forceinline__ void operator()(const f32x4 (&acc)[2][2][4][2], const Unit& u, int wr, int wc, int fr, int fq) const {
        const int col0 = u.pn * BM + wc * 32 + 8 * fq;
        f32x4 gv[2][2];
        if (NORM) {
#pragma unroll
            for (int bj = 0; bj < 2; ++bj)
#pragma unroll
                for (int n = 0; n < 2; ++n) gv[bj][n] = *(const f32x4*)(g + col0 + bj * HALF + 4 * n); }
#pragma unroll
        for (int ai = 0; ai < 2; ++ai)
#pragma unroll
        for (int mh = 0; mh < 2; ++mh) {
            f32x4 bs[2][2][2];
#pragma unroll
            for (int m2 = 0; m2 < 2; ++m2) { const size_t off = (size_t)(u.pm * BM + ai * HALF + wr * 64 + (2 * mh + m2) * 16 + fr) * ldc + col0;
#pragma unroll
                for (int bj = 0; bj < 2; ++bj)
#pragma unroll
                    for (int n = 0; n < 2; ++n) bs[m2][bj][n] = *(const f32x4*)(base + off + bj * HALF + 4 * n); }
#pragma unroll
            for (int m2 = 0; m2 < 2; ++m2) { const int m = 2 * mh + m2; const int row = u.pm * BM + ai * HALF + wr * 64 + m * 16 + fr; const size_t off = (size_t)row * ldc + col0;
                float ss = 0.f;
#pragma unroll
                for (int bj = 0; bj < 2; ++bj) { const f32x4 v0 = bs[m2][bj][0] + acc[ai][bj][m][0], v1 = bs[m2][bj][1] + acc[ai][bj][m][1];
                    *(f32x4*)(out + off + bj * HALF) = v0; *(f32x4*)(out + off + bj * HALF + 4) = v1;
                    if (NORM) { ss += (v0[0] * v0[0] + v0[1] * v0[1]) + (v0[2] * v0[2] + v0[3] * v0[3]) + (v1[0] * v1[0] + v1[1] * v1[1]) + (v1[2] * v1[2] + v1[3] * v1[3]);
                        const f32x4 y0 = v0 * gv[bj][0], y1 = v1 * gv[bj][1];
                        u32x4 w; w.x = cvt_pk_bf16(y0[0], y0[1]); w.y = cvt_pk_bf16(y0[2], y0[3]); w.z = cvt_pk_bf16(y1[0], y1[1]); w.w = cvt_pk_bf16(y1[2], y1[3]);
                        *(u32x4*)(XG + off + bj * HALF) = w; } }
                if (NORM) { ss += __shfl_xor(ss, 16); ss += __shfl_xor(ss, 32); if (fq == 0) unsafeAtomicAdd(SSQ + row, ss); } }
            asm volatile("" ::: "memory"); }
    }
};
template <class Epi, class Sched, bool ALIGN_EPI = false, bool SP2 = false>
__device__ __forceinline__ void gemm_phase(PG8_LAS unsigned char* lds, const Gemm g, const Sched& S, const Epi& E) {
    int tid_ = threadIdx.x; asm volatile("" : "+v"(tid_));
    const int tid = tid_, wid = __builtin_amdgcn_readfirstlane(tid >> 6), lane = tid & 63, wr = wid >> 2, wc = wid & 3, fr = lane & 15, fq = lane >> 4;
    const int K = g.K, nt = K / BK;
    unsigned voffA[2], voffB[2];
#pragma unroll
    for (int i = 0; i < 2; ++i) { int R, C; stage_rc(tid * 16 + i * 8192, R, C); const int Rb = Epi::PERM ? ((R & ~31) + perm32(R & 31)) : R;
        voffA[i] = (unsigned)(R * K + C) * 2u; voffB[i] = (unsigned)(Rb * K + C) * 2u; }
    const size_t kstep = (size_t)(BK * 2);
    const size_t hstep = (size_t)HALF * K * 2;
    const size_t tstep = 2 * hstep;
    const unsigned ldsw = (unsigned)wid * 1024u;
    const int aoff = lds_byte(wr * 64 + fr, fq * 8), boff = lds_byte(wc * 32 + fr, fq * 8);
#define PG8_SA(b, h) (((b) * 2 + (h)) * HTB)
#define PG8_SB(b, h) ((4 + (b) * 2 + (h)) * HTB)
#define PG8_STAGE(bufoff, gbase, voff) do { _Pragma("unroll") for (int _i = 0; _i < 2; ++_i) \
        __builtin_amdgcn_global_load_lds((const unsigned*)((const char*)(gbase) + (voff)[_i]), (PG8_LAS unsigned*)(lds + (bufoff) + ldsw + _i * 8192), 16, 0, 0); } while (0)
#define PG8_LDA(dst, b, h) do { _Pragma("unroll") for (int m = 0; m < 4; ++m) _Pragma("unroll") for (int k = 0; k < 2; ++k) dst[m][k] = *(const PG8_LAS bf16x8*)(lds + PG8_SA(b, h) + aoff + m * 2048 + k * 1024); } while (0)
#define PG8_LDB(dst, b, h) do { _Pragma("unroll") for (int n = 0; n < 2; ++n) _Pragma("unroll") for (int k = 0; k < 2; ++k) dst[n][k] = *(const PG8_LAS bf16x8*)(lds + PG8_SB(b, h) + boff + n * 2048 + k * 1024); } while (0)
#define PG8_MMA(ai, bj, At, Bt) do { __builtin_amdgcn_s_setprio(1); _Pragma("unroll") for (int m = 0; m < 4; ++m) _Pragma("unroll") for (int n = 0; n < 2; ++n) _Pragma("unroll") for (int k = 0; k < 2; ++k) \
        acc[ai][bj][m][n] = __builtin_amdgcn_mfma_f32_16x16x32_bf16(Bt[n][k], At[m][k], acc[ai][bj][m][n], 0, 0, 0); __builtin_amdgcn_s_setprio(0); } while (0)
#define PG8_WAIT_V(n) asm volatile("s_waitcnt vmcnt(" #n ")" ::: "memory")
#define PG8_WAIT_L(n) asm volatile("s_waitcnt lgkmcnt(" #n ")" ::: "memory")
#define PG8_BAR __builtin_amdgcn_s_barrier()
#define PG8_SCHED __builtin_amdgcn_sched_barrier(0)
    Unit cur, nxt; int ui = 0;
    if (!S.next(0, cur)) return;
    f32x4 acc[2][2][4][2];
#pragma unroll
    for (int a = 0; a < 2; ++a)
#pragma unroll
        for (int b = 0; b < 2; ++b)
#pragma unroll
            for (int m = 0; m < 4; ++m)
#pragma unroll
                for (int n = 0; n < 2; ++n) acc[a][b][m][n] = (f32x4){0.f, 0.f, 0.f, 0.f};
    bf16x8 At[4][2], B0[2][2], B1[2][2];
    const char* cA = (const char*)g.A + (size_t)cur.pm * tstep; const char* cB = (const char*)g.Bt + (size_t)cur.pn * tstep;
    S.a_ready(cur);
    if constexpr (SP2) {
        PG8_STAGE(PG8_SB(0, 0), cB, voffB); PG8_STAGE(PG8_SB(0, 1), cB + hstep, voffB); PG8_STAGE(PG8_SA(0, 0), cA, voffA); PG8_STAGE(PG8_SA(0, 1), cA + hstep, voffA);
        if (wr == 1) PG8_BAR;
        PG8_WAIT_V(2); PG8_BAR;
        PG8_STAGE(PG8_SB(1, 0), cB + kstep, voffB); PG8_STAGE(PG8_SA(1, 0), cA + kstep, voffA); PG8_STAGE(PG8_SB(1, 1), cB + hstep + kstep, voffB);
        PG8_WAIT_V(6); PG8_BAR;
    } else {
        PG8_STAGE(PG8_SB(0, 0), cB, voffB); PG8_STAGE(PG8_SA(0, 0), cA, voffA); PG8_STAGE(PG8_SB(0, 1), cB + hstep, voffB); PG8_STAGE(PG8_SA(0, 1), cA + hstep, voffA);
        if (wr == 1) PG8_BAR;
        PG8_WAIT_V(4); PG8_BAR;
        PG8_STAGE(PG8_SB(1, 0), cB + kstep, voffB); PG8_STAGE(PG8_SA(1, 0), cA + kstep, voffA); PG8_STAGE(PG8_SB(1, 1), cB + hstep + kstep, voffB);
        PG8_WAIT_V(6); PG8_BAR;
    }
    for (;;) {
        const bool has_next = S.next(ui + 1, nxt);
        const char* nA = has_next ? (const char*)g.A + (size_t)nxt.pm * tstep : cA; const char* nB = has_next ? (const char*)g.Bt + (size_t)nxt.pn * tstep : cB;
        for (int t = 0; t < nt; t += 2) {
            const bool last = (t == nt - 2);
            const char* a1 = cA + (size_t)(t + 1) * kstep;
            const char* a2 = last ? nA : cA + (size_t)(t + 2) * kstep; const char* b2 = last ? nB : cB + (size_t)(t + 2) * kstep;
            const char* a3 = a2 + kstep; const char* b3 = b2 + kstep;
            if (last && has_next) S.a_ready(nxt);
            if constexpr (SP2) {
            PG8_LDB(B0, 0, 0); PG8_LDB(B1, 0, 1); PG8_SCHED; PG8_LDA(At, 0, 0); PG8_STAGE(PG8_SA(1, 1), a1 + hstep, voffA);
            PG8_WAIT_V(8); PG8_WAIT_L(0); PG8_BAR; PG8_MMA(0, 0, At, B0); PG8_MMA(0, 1, At, B1); PG8_BAR; PG8_SCHED;
            PG8_LDA(At, 0, 1); PG8_STAGE(PG8_SB(0, 0), b2, voffB); PG8_STAGE(PG8_SB(0, 1), b2 + hstep, voffB); PG8_STAGE(PG8_SA(0, 0), a2, voffA);
            PG8_WAIT_V(8); PG8_WAIT_L(0); PG8_BAR; PG8_MMA(1, 0, At, B0); PG8_MMA(1, 1, At, B1); PG8_BAR; PG8_SCHED;
            PG8_LDB(B0, 1, 0); PG8_LDB(B1, 1, 1); PG8_SCHED; PG8_LDA(At, 1, 0); PG8_STAGE(PG8_SA(0, 1), a2 + hstep, voffA);
            PG8_WAIT_V(8); PG8_WAIT_L(0); PG8_BAR; PG8_MMA(0, 0, At, B0); PG8_MMA(0, 1, At, B1); PG8_BAR; PG8_SCHED;
            PG8_LDA(At, 1, 1); PG8_STAGE(PG8_SB(1, 0), b3, voffB); PG8_STAGE(PG8_SB(1, 1), b3 + hstep, voffB); PG8_STAGE(PG8_SA(1, 0), a3, voffA);
            PG8_WAIT_V(8); PG8_WAIT_L(0); PG8_BAR; PG8_MMA(1, 0, At, B0); PG8_MMA(1, 1, At, B1); PG8_BAR; PG8_SCHED;
            } else {
            PG8_LDB(B0, 0, 0); PG8_SCHED; PG8_LDA(At, 0, 0); PG8_STAGE(PG8_SA(1, 1), a1 + hstep, voffA);
            PG8_WAIT_L(8); PG8_BAR; PG8_WAIT_L(0); PG8_MMA(0, 0, At, B0); PG8_BAR; PG8_SCHED;
            PG8_LDB(B1, 0, 1); PG8_STAGE(PG8_SB(0, 0), b2, voffB);
            PG8_BAR; PG8_WAIT_L(0); PG8_MMA(0, 1, At, B1); PG8_BAR;
            PG8_LDA(At, 0, 1); PG8_STAGE(PG8_SA(0, 0), a2, voffA);
            PG8_BAR; PG8_WAIT_L(0); PG8_MMA(1, 0, At, B0); PG8_BAR; PG8_SCHED;
            PG8_STAGE(PG8_SB(0, 1), b2 + hstep, voffB);
            PG8_WAIT_V(6); PG8_BAR; PG8_MMA(1, 1, At, B1); PG8_BAR;
            PG8_LDB(B0, 1, 0); PG8_SCHED; PG8_LDA(At, 1, 0); PG8_STAGE(PG8_SA(0, 1), a2 + hstep, voffA);
            PG8_WAIT_L(8); PG8_BAR; PG8_WAIT_L(0); PG8_MMA(0, 0, At, B0); PG8_BAR; PG8_SCHED;
            PG8_LDB(B1, 1, 1); PG8_STAGE(PG8_SB(1, 0), b3, voffB);
            PG8_BAR; PG8_WAIT_L(0); PG8_MMA(0, 1, At, B1); PG8_BAR;
            PG8_LDA(At, 1, 1); PG8_STAGE(PG8_SA(1, 0), a3, voffA);
            PG8_BAR; PG8_WAIT_L(0); PG8_MMA(1, 0, At, B0); PG8_BAR; PG8_SCHED;
            PG8_STAGE(PG8_SB(1, 1), b3 + hstep, voffB);
            PG8_WAIT_V(6); PG8_BAR; PG8_MMA(1, 1, At, B1); PG8_BAR;
            }
        }
        if constexpr (ALIGN_EPI) { if (wr == 0) PG8_BAR; }
        if constexpr (!Epi::AFTER_DRAIN) { E(acc, cur, wr, wc, fr, fq); S.done(cur); }
        if (!has_next) break;
#pragma unroll
        for (int a = 0; a < 2; ++a)
#pragma unroll
            for (int b = 0; b < 2; ++b)
#pragma unroll
                for (int m = 0; m < 4; ++m)
#pragma unroll
                    for (int n = 0; n < 2; ++n) acc[a][b][m][n] = (f32x4){0.f, 0.f, 0.f, 0.f};
        cur = nxt; cA = nA; cB = nB; ++ui;
        if constexpr (ALIGN_EPI) { if (wr == 1) PG8_BAR; }
    }
    PG8_WAIT_V(0);
    if constexpr (!ALIGN_EPI) { if (wr == 0) PG8_BAR; }
    PG8_BAR;
    if constexpr (Epi::AFTER_DRAIN) { E.fused(acc, cur, wr, wc, fr, fq, lds, wid, lane); S.done(cur); }
#undef PG8_SA
#undef PG8_SB
#undef PG8_STAGE
#undef PG8_LDA
#undef PG8_LDB
#undef PG8_MMA
#undef PG8_WAIT_V
#undef PG8_WAIT_L
#undef PG8_BAR
#undef PG8_SCHED
}
}
constexpr int SEQ = 8192, DM = 2048, M = 16384, DEPTH = 2, INW = 4624, LDP = 4864, DFF = 8192;
constexpr int C_AQ = 0, C_AK = 1024, C_AV = 1280, C_GQ = 1536, C_GK = 2048, C_GV = 2560, C_GR = 3584, C_GZ = 4608;
constexpr float EPS = 1e-6f;
constexpr int NWAVES = 8, NT = 512;
constexpr size_t MiB = 1u << 20;
constexpr size_t WS_WIN = 1 * MiB, WS_WOUT = 20 * MiB, WS_WUP = 28 * MiB, WS_WDN = 60 * MiB, WS_XN = 92 * MiB;
constexpr size_t WS_U = 156 * MiB, WS_PROJ = 156 * MiB, WS_MIX = 308 * MiB, WS_KVS = 412 * MiB, WS_DEC = 476 * MiB, WS_END = 477 * MiB;
static_assert(WS_PROJ + (size_t)M * LDP * 2 <= WS_MIX && WS_MIX + (size_t)M * DM * 2 <= WS_KVS && WS_U + (size_t)M * DFF * 2 <= WS_KVS, "ws map");
constexpr int LDS_BYTES = 147456;

#define LAS __attribute__((address_space(3)))
typedef unsigned short bf16;
typedef float f32x4 __attribute__((ext_vector_type(4)));
typedef float f32x16 __attribute__((ext_vector_type(16)));
typedef short bf16x8 __attribute__((ext_vector_type(8)));
typedef unsigned u32x4 __attribute__((ext_vector_type(4)));
typedef unsigned u32x2 __attribute__((ext_vector_type(2)));
#define MFMA32(a, b, c) __builtin_amdgcn_mfma_f32_32x32x16_bf16((a), (b), (c), 0, 0, 0)

__device__ __forceinline__ float bflo(unsigned u) { return __uint_as_float(u << 16); }
__device__ __forceinline__ float bfhi(unsigned u) { return __uint_as_float(u & 0xffff0000u); }
__device__ __forceinline__ unsigned pk(float lo, float hi) { return pg8::cvt_pk_bf16(lo, hi); }
__device__ __forceinline__ float wave_sum(float v) {
#pragma unroll
    for (int o = 1; o < 64; o <<= 1) v += __shfl_xor(v, o);
    return v;
}

__device__ __forceinline__ void transpose_item(const float* W, int K, int Nsrc, int Npad, bf16* WT, LAS float* scr, int item, int lane) {
    const int nblk = Npad / 128, kb = item / nblk, nb = item % nblk, k0 = 32 * kb, n0 = 128 * nb;
    const int nl = (lane & 31) * 4, kr = lane >> 5; const bool ok = (n0 + nl) < Nsrc;
    f32x4 v[16];
#pragma unroll
    for (int i = 0; i < 16; ++i) v[i] = ok ? __builtin_nontemporal_load((const f32x4*)(W + (size_t)(k0 + 2 * i + kr) * Nsrc + n0 + nl)) : (f32x4){0.f, 0.f, 0.f, 0.f};
#pragma unroll
    for (int i = 0; i < 16; ++i) { LAS float* s = scr + (2 * i + kr) * 129 + nl; s[0] = v[i].x; s[1] = v[i].y; s[2] = v[i].z; s[3] = v[i].w; }
    asm volatile("s_waitcnt lgkmcnt(0)" ::: "memory");
    const int nn = lane >> 2, kq = lane & 3;
#pragma unroll
    for (int j = 0; j < 8; ++j) { const int n = j * 16 + nn; const LAS float* s = scr + (kq * 8) * 129 + n;
        u32x4 o; o.x = pk(s[0 * 129], s[1 * 129]); o.y = pk(s[2 * 129], s[3 * 129]); o.z = pk(s[4 * 129], s[5 * 129]); o.w = pk(s[6 * 129], s[7 * 129]);
        *(u32x4*)(WT + (size_t)(n0 + n) * K + k0 + kq * 8) = o; }
    asm volatile("s_waitcnt lgkmcnt(0)" ::: "memory");
}
__device__ __forceinline__ void prep_row(const float* xrow, const float* g, bf16* orow, float* ssq, int lane) {
    const f32x4* xr = (const f32x4*)xrow + lane; f32x4 v[8]; float s = 0.f;
#pragma unroll
    for (int j = 0; j < 8; ++j) { v[j] = __builtin_nontemporal_load(xr + 64 * j); s += (v[j].x * v[j].x + v[j].y * v[j].y) + (v[j].z * v[j].z + v[j].w * v[j].w); }
    s = wave_sum(s); if (lane == 0) *ssq = s;
    u32x2* o8 = (u32x2*)orow + lane; const f32x4* gr = (const f32x4*)g + lane;
#pragma unroll
    for (int j = 0; j < 8; ++j) { const f32x4 gg = gr[64 * j]; u32x2 w; w.x = pk(v[j].x * gg.x, v[j].y * gg.y); w.y = pk(v[j].z * gg.z, v[j].w * gg.w); o8[64 * j] = w; }
}

constexpr int CONV_NQ = 2304;
struct ConvJob { const float* W; bf16* WT; int K, N; };
__device__ __forceinline__ bool conv_decode(int q, const float* w_out, const float* w_up, const float* w_dn, bf16* WoutT, bf16* WupT, bf16* WdnT, ConvJob& j, int& k0, int& n0) {
    if (q >= CONV_NQ) return false;
    if (q < 256) { j.W = w_out; j.WT = WoutT; j.K = DM; j.N = DM; k0 = (q >> 3) * 64; n0 = (q & 7) * 256; }
    else if (q < 1280) { const int r = q - 256; j.W = w_up; j.WT = WupT; j.K = DM; j.N = DFF; k0 = (r >> 5) * 64; n0 = (r & 31) * 256; }
    else { const int r = q - 1280; j.W = w_dn; j.WT = WdnT; j.K = DFF; j.N = DM; k0 = (r >> 3) * 64; n0 = (r & 7) * 256; }
    return true;
}
struct ConvCtx { const float* w_out; const float* w_up; const float* w_dn; bf16* WoutT; bf16* WupT; bf16* WdnT; };
__device__ __forceinline__ void conv_load(const ConvCtx& cx, int q, int tid, f32x4 (&v)[8]) {
    ConvJob j; int k0, n0;
    if (!conv_decode(q, cx.w_out, cx.w_up, cx.w_dn, cx.WoutT, cx.WupT, cx.WdnT, j, k0, n0)) return;
    const float* p = j.W + (size_t)(k0 + ((tid & 63) >> 3) * 8) * j.N + n0 + (tid >> 6) * 32 + (tid & 7) * 4;
#pragma unroll
    for (int r = 0; r < 8; ++r) v[r] = __builtin_nontemporal_load((const f32x4*)(p + (size_t)r * j.N));
}
__device__ __forceinline__ void conv_store(const ConvCtx& cx, int q, int tid, const f32x4 (&v)[8]) {
    ConvJob j; int k0, n0;
    if (!conv_decode(q, cx.w_out, cx.w_up, cx.w_dn, cx.WoutT, cx.WupT, cx.WdnT, j, k0, n0)) return;
    bf16* p = j.WT + (size_t)(n0 + (tid >> 6) * 32 + (tid & 7) * 4) * j.K + k0 + ((tid & 63) >> 3) * 8;
#pragma unroll
    for (int i = 0; i < 4; ++i) { u32x4 o; o.x = pk(v[0][i], v[1][i]); o.y = pk(v[2][i], v[3][i]); o.z = pk(v[4][i], v[5][i]); o.w = pk(v[6][i], v[7][i]); *(u32x4*)(p + (size_t)i * j.K) = o; }
}

__device__ __forceinline__ void attn_item(LAS unsigned char* lds, int item, const bf16* PROJ, bf16* MIX, const float* qng, const float* kng, const float* sinks, const ConvCtx& cx, int cq, int tid, int lane, int wid) {
    const int kvh = item & 3, blk = (item >> 2) & 63, b = item >> 8;
    f32x4 cv[8];
    LAS unsigned char* Ks = lds; LAS unsigned short* Vt = (LAS unsigned short*)(lds + 36864);
    const size_t tok0 = (size_t)b * SEQ + (size_t)blk * 128;
    const int g = wid >> 1, rh = wid & 1, qh = kvh * 4 + g, h = lane >> 5, c = lane & 31;
    u32x4 qq[2][4];
    { const bf16* qp = PROJ + (tok0 + rh * 64 + c) * LDP + C_AQ + qh * 64 + h * 8;
#pragma unroll
        for (int kk = 0; kk < 4; ++kk) qq[0][kk] = *(const u32x4*)(qp + 16 * kk); }
    {
        const int key = tid >> 1, hf = tid & 1; const bool ok = (blk > 0) || (key >= 128);
        u32x4 kq[4], vq[4];
        if (ok) { const bf16* p = PROJ + (tok0 + key - 128) * LDP + C_AK + kvh * 64 + hf * 32;
#pragma unroll
            for (int i = 0; i < 4; ++i) { kq[i] = *(const u32x4*)(p + 8 * i); vq[i] = *(const u32x4*)(p + 256 + 8 * i); } }
        else {
#pragma unroll
            for (int i = 0; i < 4; ++i) { kq[i] = (u32x4){0u, 0u, 0u, 0u}; vq[i] = (u32x4){0u, 0u, 0u, 0u}; } }
        conv_load(cx, cq, tid, cv);
        float kf[32]; float ss = 0.f;
#pragma unroll
        for (int i = 0; i < 4; ++i)
#pragma unroll
            for (int c = 0; c < 4; ++c) { kf[i * 8 + 2 * c] = bflo(kq[i][c]); kf[i * 8 + 2 * c + 1] = bfhi(kq[i][c]); }
#pragma unroll
        for (int i = 0; i < 32; ++i) ss += kf[i] * kf[i];
        ss += __shfl_xor(ss, 1);
        const float rstd = rsqrtf(ss * (1.f / 64.f) + EPS);
#pragma unroll
        for (int i = 0; i < 4; ++i) { u32x4 w;
#pragma unroll
            for (int c = 0; c < 4; ++c) { const int d = hf * 32 + i * 8 + 2 * c; w[c] = pk(kf[i * 8 + 2 * c] * rstd * kng[d], kf[i * 8 + 2 * c + 1] * rstd * kng[d + 1]); }
            *(LAS u32x4*)(Ks + key * 144 + hf * 64 + i * 16) = w; }
#pragma unroll
        for (int i = 0; i < 4; ++i)
#pragma unroll
            for (int c = 0; c < 4; ++c) { const int d = hf * 32 + i * 8 + 2 * c; Vt[d * 260 + key] = (unsigned short)(vq[i][c] & 0xffffu); Vt[(d + 1) * 260 + key] = (unsigned short)(vq[i][c] >> 16); }
    }
    __syncthreads();
    conv_store(cx, cq, tid, cv);
    { const bf16* qp = PROJ + (tok0 + rh * 64 + 32 + c) * LDP + C_AQ + qh * 64 + h * 8;
#pragma unroll
        for (int kk = 0; kk < 4; ++kk) qq[1][kk] = *(const u32x4*)(qp + 16 * kk); }
    const float L2E = 1.4426950408889634f;
    const float slope2 = exp2f(-0.5f * (float)(qh + 1)) * L2E, sink2 = sinks[qh] * L2E;
    const int cm = c - 4 * h;
    const float base = -slope2 * (float)cm;
#pragma unroll 1
    for (int sb = 0; sb < 2; ++sb) {
        const int i0 = rh * 64 + sb * 32, qi = i0 + c;
        float qf[32]; float ss = 0.f;
#pragma unroll
        for (int kk = 0; kk < 4; ++kk)
#pragma unroll
            for (int cc = 0; cc < 4; ++cc) { const unsigned qw = sb ? qq[1][kk][cc] : qq[0][kk][cc]; qf[kk * 8 + 2 * cc] = bflo(qw); qf[kk * 8 + 2 * cc + 1] = bfhi(qw); }
#pragma unroll
        for (int i = 0; i < 32; ++i) ss += qf[i] * qf[i];
        ss += __shfl_xor(ss, 32);
        const float rstd = rsqrtf(ss * (1.f / 64.f) + EPS) * (0.125f * L2E);
        bf16x8 qb[4];
#pragma unroll
        for (int kk = 0; kk < 4; ++kk) { u32x4 w;
#pragma unroll
            for (int cc = 0; cc < 4; ++cc) { const int d = h * 8 + 16 * kk + 2 * cc; w[cc] = pk(qf[kk * 8 + 2 * cc] * rstd * qng[d], qf[kk * 8 + 2 * cc + 1] * rstd * qng[d + 1]); }
            qb[kk] = __builtin_bit_cast(bf16x8, w); }
        f32x16 s[5];
#pragma unroll
        for (int T = 0; T < 5; ++T) {
#pragma unroll
            for (int r = 0; r < 16; ++r) s[T][r] = 0.f;
#pragma unroll
            for (int kk = 0; kk < 4; ++kk) { const bf16x8 a = *(const LAS bf16x8*)(Ks + (i0 + 32 * T + c) * 144 + (h * 8 + 16 * kk) * 2); s[T] = MFMA32(a, qb[kk], s[T]); }
        }
        float mx = -1e30f;
#pragma unroll
        for (int T = 0; T < 5; ++T) {
            const bool dead = (blk == 0) && (i0 + 32 * T < 128);
#pragma unroll
            for (int r = 0; r < 16; ++r) { const int ep = 8 * (r >> 2) + (r & 3); float x = __builtin_fmaf(slope2, (float)(32 * T + ep - 128), s[T][r]);
                if (T == 0) x = (ep > cm) ? x : -1e30f;
                if (T == 4) x = (ep <= cm) ? x : -1e30f;
                if (dead) x = -1e30f;
                s[T][r] = x; mx = fmaxf(mx, x); } }
        float mrow = mx + base; mrow = fmaxf(mrow, __shfl_xor(mrow, 32)); mrow = fmaxf(mrow, sink2);
        const float mp = mrow - base;
        float sum = 0.f;
#pragma unroll
        for (int T = 0; T < 5; ++T)
#pragma unroll
            for (int r = 0; r < 16; ++r) { const float p = __builtin_amdgcn_exp2f(s[T][r] - mp); s[T][r] = p; sum += p; }
        sum += __shfl_xor(sum, 32); sum += __builtin_amdgcn_exp2f(sink2 - mrow);
        const float inv = 1.f / sum;
        f32x16 o[2];
#pragma unroll
        for (int mt = 0; mt < 2; ++mt)
#pragma unroll
            for (int r = 0; r < 16; ++r) o[mt][r] = 0.f;
#pragma unroll
        for (int T = 0; T < 5; ++T)
#pragma unroll
            for (int u = 0; u < 2; ++u) { u32x4 w;
#pragma unroll
                for (int cc = 0; cc < 4; ++cc) w[cc] = pk(s[T][8 * u + 2 * cc], s[T][8 * u + 2 * cc + 1]);
                const bf16x8 pb = __builtin_bit_cast(bf16x8, w);
#pragma unroll
                for (int mt = 0; mt < 2; ++mt) { const LAS unsigned short* vp = Vt + (mt * 32 + c) * 260 + i0 + 32 * T + 16 * u + 4 * h;
                    const u32x2 lo = *(const LAS u32x2*)vp, hi = *(const LAS u32x2*)(vp + 8);
                    const u32x4 av = {lo.x, lo.y, hi.x, hi.y}; o[mt] = MFMA32(__builtin_bit_cast(bf16x8, av), pb, o[mt]); } }
        bf16* op = MIX + (tok0 + qi) * DM + qh * 64 + 4 * h;
#pragma unroll
        for (int mt = 0; mt < 2; ++mt)
#pragma unroll
            for (int q4 = 0; q4 < 4; ++q4) { u32x2 w; w.x = pk(o[mt][4 * q4] * inv, o[mt][4 * q4 + 1] * inv); w.y = pk(o[mt][4 * q4 + 2] * inv, o[mt][4 * q4 + 3] * inv); *(u32x2*)(op + mt * 32 + 8 * q4) = w; }
    }
    __syncthreads();
}

constexpr int GL_GZS = 33792, GL_SEG = 37888, GL_QI = 39936, GL_KI = 58368, GL_AT = 75776, GL_VT = 84992;
__device__ __forceinline__ void gla_gate(LAS unsigned char* lds, unsigned gzw, const float (&w)[16], float bias, int tid) {
    LAS float* BsT = (LAS float*)lds; LAS float* gzs = (LAS float*)(lds + GL_GZS); LAS float* seg = (LAS float*)(lds + GL_SEG);
    { const int t = tid >> 3, r2 = (tid & 7) * 2; gzs[t * 16 + r2] = bflo(gzw); gzs[t * 16 + r2 + 1] = bfhi(gzw); }
    const int j = tid & 127, tq = tid >> 7;
    __syncthreads();
    float val[16]; float run = 0.f;
#pragma unroll
    for (int i = 0; i < 16; ++i) { const LAS f32x4* zp = (const LAS f32x4*)(gzs + (tq * 16 + i) * 16); float z = bias;
#pragma unroll
        for (int v = 0; v < 4; ++v) { const f32x4 zz = zp[v]; z += zz.x * w[4 * v] + zz.y * w[4 * v + 1] + zz.z * w[4 * v + 2] + zz.w * w[4 * v + 3]; }
        const float ls = fminf(z, 0.f) - __logf(1.f + __expf(-fabsf(z))); run += ls * (1.f / 16.f); val[i] = run; }
    seg[tq * 128 + j] = run;
    __syncthreads();
    float off = 0.f;
#pragma unroll
    for (int q = 0; q < 3; ++q) if (q < tq) off += seg[q * 128 + j];
#pragma unroll
    for (int i = 0; i < 16; ++i) BsT[j * 65 + tq * 16 + i] = val[i] + off;
    __syncthreads();
}
__device__ __forceinline__ void gla_scatter_vt(LAS unsigned char* lds, const u32x4 (&vq)[4], int tid) {
    LAS unsigned short* VT = (LAS unsigned short*)(lds + GL_VT); const int t = tid & 63, cw = tid >> 6;
#pragma unroll
    for (int i = 0; i < 4; ++i)
#pragma unroll
        for (int e = 0; e < 4; ++e) { const int c = 8 * (cw + 8 * i) + 2 * e; VT[c * 72 + t] = (unsigned short)(vq[i][e] & 0xffffu); VT[(c + 1) * 72 + t] = (unsigned short)(vq[i][e] >> 16); }
}
constexpr int GL_KST = 121856;
__device__ __forceinline__ void gla_stage_kst(LAS unsigned char* lds, LAS unsigned short* KsT, const u32x4 (&kq)[2], int tid) {
    LAS float* BsT = (LAS float*)lds; LAS float* decs = (LAS float*)(lds + GL_SEG); const int t = tid & 63, cw = tid >> 6;
#pragma unroll
    for (int i = 0; i < 2; ++i)
#pragma unroll
        for (int e = 0; e < 4; ++e) { const int j = 8 * (cw + 8 * i) + 2 * e;
            const float e0 = __expf(BsT[j * 65 + 63] - BsT[j * 65 + t]), e1 = __expf(BsT[(j + 1) * 65 + 63] - BsT[(j + 1) * 65 + t]);
            const unsigned w = pk(bflo(kq[i][e]) * e0, bfhi(kq[i][e]) * e1);
            KsT[j * 72 + t] = (unsigned short)(w & 0xffffu); KsT[(j + 1) * 72 + t] = (unsigned short)(w >> 16); }
    if (tid < 128) decs[tid] = __expf(BsT[tid * 65 + 63]);
}
__device__ __forceinline__ void gla_state_update(LAS unsigned char* lds, const LAS unsigned short* KsT, const bf16x8 (&bv)[4], f32x16 (&S)[4], bool first, int h, int c) {
    const LAS float* decs = (const LAS float*)(lds + GL_SEG);
#pragma unroll
    for (int mt = 0; mt < 4; ++mt) { f32x16 acc;
#pragma unroll
        for (int r = 0; r < 16; ++r) acc[r] = 0.f;
#pragma unroll
        for (int ks = 0; ks < 4; ++ks) { const bf16x8 a = *(const LAS bf16x8*)(KsT + (mt * 32 + c) * 72 + h * 8 + 16 * ks); acc = MFMA32(a, bv[ks], acc); }
        if (first) S[mt] = acc;
        else {
#pragma unroll
            for (int q = 0; q < 4; ++q) { const f32x4 d = *(const LAS f32x4*)(decs + mt * 32 + 8 * q + 4 * h);
#pragma unroll
                for (int e = 0; e < 4; ++e) S[mt][4 * q + e] = S[mt][4 * q + e] * d[e] + acc[4 * q + e]; } }
        __builtin_amdgcn_sched_barrier(0); }
}
__device__ __forceinline__ void gla_local_group(LAS unsigned char* lds, int g, const bf16* PROJ, bf16* KVS, float* DEC, const float (&gwr)[16], float gbias, const ConvCtx& cx, int cq0, int tid, int lane, int wid) {
    const int hh = g & 3, gi = (g >> 2) & 31, b = g >> 7; const int t = tid & 63, cw = tid >> 6, h = lane >> 5, c = lane & 31;
    LAS float* BsT = (LAS float*)lds; LAS unsigned short* KsT = (LAS unsigned short*)(lds + GL_QI); LAS unsigned short* VT = (LAS unsigned short*)(lds + GL_VT);
    f32x16 S[4]; float blsum = 0.f;
#pragma unroll 1
    for (int j = 0; j < 4; ++j) {
        const size_t R0 = (size_t)b * SEQ + (size_t)(gi * 4 + j) * 64; const int cq = cq0 + j * 256;
        f32x4 cv[8];
        const unsigned gzw = *(const unsigned*)(PROJ + (R0 + (tid >> 3)) * LDP + C_GZ + (tid & 7) * 2);
        u32x4 kq[2], vq[4];
        { const bf16* rp = PROJ + (R0 + t) * LDP;
#pragma unroll
            for (int i = 0; i < 2; ++i) kq[i] = *(const u32x4*)(rp + C_GK + hh * 128 + 8 * (cw + 8 * i));
#pragma unroll
            for (int i = 0; i < 4; ++i) vq[i] = *(const u32x4*)(rp + C_GV + hh * 256 + 8 * (cw + 8 * i)); }
        conv_load(cx, cq, tid, cv);
        gla_gate(lds, gzw, gwr, gbias, tid);
        conv_store(cx, cq, tid, cv);
        gla_scatter_vt(lds, vq, tid);
        gla_stage_kst(lds, KsT, kq, tid);
        if (tid < 128) blsum += BsT[tid * 65 + 63];
        __syncthreads();
        { bf16x8 bv[4];
#pragma unroll
            for (int ks = 0; ks < 4; ++ks) bv[ks] = *(const LAS bf16x8*)(VT + (wid * 32 + c) * 72 + h * 8 + 16 * ks);
            gla_state_update(lds, KsT, bv, S, j == 0, h, c); }
        __syncthreads();
    }
    { bf16* outp = KVS + (size_t)((b * 4 + hh) * 32 + gi) * 32768 + (size_t)(wid * 32 + c) * 128 + 4 * h;
#pragma unroll
        for (int mt = 0; mt < 4; ++mt)
#pragma unroll
            for (int q = 0; q < 4; ++q) { u32x2 w; w.x = pk(S[mt][4 * q], S[mt][4 * q + 1]); w.y = pk(S[mt][4 * q + 2], S[mt][4 * q + 3]); *(u32x2*)(outp + mt * 32 + 8 * q) = w; }
        if (tid < 128) DEC[(size_t)((b * 4 + hh) * 32 + gi) * 128 + tid] = __expf(blsum); }
}
__device__ __forceinline__ void gla_out_group(LAS unsigned char* lds, int g, const bf16* PROJ, const bf16* KVS, bf16* MIX, const float* ggw, const float* ggb, const float* gng, const ConvCtx& cx, int cq0, int tid_in, int lane_in, int wid) {
    const int hh = g & 3, gi = (g >> 2) & 31, b = g >> 7;
    LAS float* BsT = (LAS float*)lds; LAS unsigned short* Qi = (LAS unsigned short*)(lds + GL_QI); LAS unsigned short* Ki = (LAS unsigned short*)(lds + GL_KI);
    LAS unsigned short* At = (LAS unsigned short*)(lds + GL_AT); LAS unsigned short* VT = (LAS unsigned short*)(lds + GL_VT); LAS float* Ob = (LAS float*)lds;
    LAS unsigned short* KsT = (LAS unsigned short*)(lds + GL_KST);
    f32x16 S[4];
    { const int h = lane_in >> 5, c = lane_in & 31; const bf16* sp = KVS + (size_t)((b * 4 + hh) * 32 + gi) * 32768 + (size_t)(wid * 32 + c) * 128 + 4 * h;
#pragma unroll
        for (int mt = 0; mt < 4; ++mt)
#pragma unroll
            for (int q = 0; q < 4; ++q) { const u32x2 u = *(const u32x2*)(sp + mt * 32 + 8 * q); S[mt][4 * q] = bflo(u.x); S[mt][4 * q + 1] = bfhi(u.x); S[mt][4 * q + 2] = bflo(u.y); S[mt][4 * q + 3] = bfhi(u.y); } }
    unsigned gzw_next = *(const unsigned*)(PROJ + ((size_t)b * SEQ + (size_t)(gi * 4) * 64 + (tid_in >> 3)) * LDP + C_GZ + (tid_in & 7) * 2);
    float gwr[16];
#pragma unroll
    for (int r = 0; r < 16; ++r) gwr[r] = ggw[r * 512 + hh * 128 + (tid_in & 127)];
    const float gbias = ggb[hh * 128 + (tid_in & 127)];
#pragma unroll 1
    for (int j = 0; j < 4; ++j) {
        int tid = tid_in; asm volatile("" : "+v"(tid));
        const int lane = tid & 63, t = tid & 63, cw = tid >> 6, h = lane >> 5, c = lane & 31;
        const size_t R0 = (size_t)b * SEQ + (size_t)(gi * 4 + j) * 64;
        const unsigned gzw = gzw_next;
        if (j < 3) gzw_next = *(const unsigned*)(PROJ + (R0 + 64 + (tid >> 3)) * LDP + C_GZ + (tid & 7) * 2);
        u32x4 qq[2], kq[2], vq[4]; u32x2 grv[8];
        { const bf16* rp = PROJ + (R0 + t) * LDP;
#pragma unroll
            for (int i = 0; i < 2; ++i) { qq[i] = *(const u32x4*)(rp + C_GQ + hh * 128 + 8 * (cw + 8 * i)); kq[i] = *(const u32x4*)(rp + C_GK + hh * 128 + 8 * (cw + 8 * i)); }
#pragma unroll
            for (int i = 0; i < 4; ++i) vq[i] = *(const u32x4*)(rp + C_GV + hh * 256 + 8 * (cw + 8 * i));
        }
        f32x4 cv[8]; const int cq = cq0 + j * 256; conv_load(cx, cq, tid, cv);
#pragma unroll
        for (int i = 0; i < 8; ++i) grv[i] = *(const u32x2*)(PROJ + (R0 + wid * 8 + i) * LDP + C_GR + hh * 256 + lane * 4);
        gla_gate(lds, gzw, gwr, gbias, tid);
        conv_store(cx, cq, tid, cv);
        gla_scatter_vt(lds, vq, tid);
        gla_stage_kst(lds, KsT, kq, tid);
        { const float QS = 0.08838834764831845f;
#pragma unroll
            for (int i = 0; i < 2; ++i) { const int j8 = 8 * (cw + 8 * i); u32x4 oq, ok;
#pragma unroll
                for (int e = 0; e < 4; ++e) { const float b0 = BsT[(j8 + 2 * e) * 65 + t], b1 = BsT[(j8 + 2 * e + 1) * 65 + t];
                    oq[e] = pk(bflo(qq[i][e]) * QS * __expf(b0), bfhi(qq[i][e]) * QS * __expf(b1)); ok[e] = pk(bflo(kq[i][e]) * __expf(-b0), bfhi(kq[i][e]) * __expf(-b1)); }
                *(LAS u32x4*)(Qi + t * 136 + j8) = oq; *(LAS u32x4*)(Ki + t * 136 + j8) = ok; } }
        __syncthreads();
        if (wid < 4) { const int mt = wid >> 1, nt = wid & 1; f32x16 acc;
#pragma unroll
            for (int r = 0; r < 16; ++r) acc[r] = 0.f;
#pragma unroll
            for (int ks = 0; ks < 8; ++ks) { const bf16x8 a = *(const LAS bf16x8*)(Qi + (mt * 32 + c) * 136 + h * 8 + 16 * ks), bb = *(const LAS bf16x8*)(Ki + (nt * 32 + c) * 136 + h * 8 + 16 * ks); acc = MFMA32(a, bb, acc); }
#pragma unroll
            for (int r = 0; r < 16; ++r) { const int tt = mt * 32 + 8 * (r >> 2) + 4 * h + (r & 3), ss = nt * 32 + c; At[tt * 72 + ss] = (unsigned short)((ss <= tt) ? (pk(acc[r], 0.f) & 0xffffu) : 0u); } }
        __syncthreads();
        f32x16 o[2]; bf16x8 bv[4];
#pragma unroll
        for (int mt = 0; mt < 2; ++mt)
#pragma unroll
            for (int r = 0; r < 16; ++r) o[mt][r] = 0.f;
#pragma unroll
        for (int ks = 0; ks < 4; ++ks) { bv[ks] = *(const LAS bf16x8*)(VT + (wid * 32 + c) * 72 + h * 8 + 16 * ks);
#pragma unroll
            for (int mt = 0; mt < 2; ++mt) { const bf16x8 a = *(const LAS bf16x8*)(At + (mt * 32 + c) * 72 + h * 8 + 16 * ks); o[mt] = MFMA32(a, bv[ks], o[mt]); } }
#pragma unroll
        for (int ms = 0; ms < 4; ++ms)
#pragma unroll
            for (int u = 0; u < 2; ++u) { u32x4 w;
#pragma unroll
                for (int e = 0; e < 4; ++e) w[e] = pk(S[ms][8 * u + 2 * e], S[ms][8 * u + 2 * e + 1]);
                const bf16x8 sb = __builtin_bit_cast(bf16x8, w);
#pragma unroll
                for (int mt = 0; mt < 2; ++mt) { const LAS unsigned short* qp = Qi + (mt * 32 + c) * 136 + 32 * ms + 16 * u + 4 * h;
                    const u32x2 lo = *(const LAS u32x2*)qp, hi = *(const LAS u32x2*)(qp + 8); const u32x4 av = {lo.x, lo.y, hi.x, hi.y};
                    o[mt] = MFMA32(__builtin_bit_cast(bf16x8, av), sb, o[mt]); }
            }
        gla_state_update(lds, KsT, bv, S, false, h, c);
        __syncthreads();
#pragma unroll
        for (int mt = 0; mt < 2; ++mt)
#pragma unroll
            for (int r = 0; r < 16; ++r) Ob[(mt * 32 + 8 * (r >> 2) + 4 * h + (r & 3)) * 260 + wid * 32 + c] = o[mt][r];
        __syncthreads();
        const f32x4 g4 = *(const f32x4*)(gng + lane * 4);
#pragma unroll
        for (int i = 0; i < 8; ++i) { const int tt = wid * 8 + i; const f32x4 x = *(const LAS f32x4*)(Ob + tt * 260 + lane * 4);
            const float ss = wave_sum((x.x * x.x + x.y * x.y) + (x.z * x.z + x.w * x.w)); const float rstd = rsqrtf(ss * (1.f / 256.f) + EPS);
            const float r0 = bflo(grv[i].x), r1 = bfhi(grv[i].x), r2 = bflo(grv[i].y), r3 = bfhi(grv[i].y);
            u32x2 w; w.x = pk(x.x * rstd * g4.x * (r0 / (1.f + __expf(-r0))), x.y * rstd * g4.y * (r1 / (1.f + __expf(-r1))));
            w.y = pk(x.z * rstd * g4.z * (r2 / (1.f + __expf(-r2))), x.w * rstd * g4.w * (r3 / (1.f + __expf(-r3))));
            *(u32x2*)(MIX + (R0 + tt) * DM + 1024 + hh * 256 + lane * 4) = w; }
        __syncthreads();
    }
}
#define XB_TMO      128
#define XB_XCNT(j)  (256  + 64 * (j))
#define XB_XSUB(j)  (1280 + 64 * (j))
#define XB_XGEN(j)  (2304 + 64 * (j))
#define XB_TOP      3328
#define XB_TOPGEN   3392
#define XCD_BAR_WORDS 3456
#define XB_SPIN_CAP (1u << 18)

__device__ __forceinline__ unsigned xb_ld(unsigned* p)              { return __hip_atomic_load(p, __ATOMIC_RELAXED, __HIP_MEMORY_SCOPE_AGENT); }
__device__ __forceinline__ unsigned xb_add(unsigned* p, unsigned v) { return __hip_atomic_fetch_add(p, v, __ATOMIC_RELAXED, __HIP_MEMORY_SCOPE_AGENT); }
__device__ __forceinline__ unsigned xb_xcc_id() { return (unsigned)__builtin_amdgcn_s_getreg((3 << 11) | 20) & 0xFu; }
#define XB_SPIN(cond, bar) do { unsigned _sp = 0; while (cond) { __builtin_amdgcn_s_sleep(1); \
    if ((++_sp & 255u) == 0u) { if (xb_ld(&(bar)[XB_TMO])) break; if (_sp > XB_SPIN_CAP) { atomicAdd(&(bar)[XB_TMO], 1u); break; } } } } while (0)

struct XcdBarrier {
    unsigned* bar; unsigned x;
    volatile LAS unsigned* st;
};

__device__ __forceinline__ XcdBarrier xcd_barrier_post(unsigned* bar, volatile LAS unsigned* st) {
    XcdBarrier b; b.bar = bar; b.x = xb_xcc_id(); b.st = st;
    if (threadIdx.x == 0) (void)xb_add(&bar[XB_XCNT(b.x)], 1u);
    return b;
}
__device__ __forceinline__ void xcd_barrier_complete(unsigned* bar, unsigned x, unsigned& nloc, unsigned& nx) {
    const unsigned G = gridDim.x * gridDim.y * gridDim.z;
    unsigned sum, cnt, mine, sp = 0u;
    for (;;) {
        sum = 0u; cnt = 0u; mine = 0u;
#pragma unroll
        for (unsigned j = 0; j < 16; ++j) { const unsigned c = xb_ld(&bar[XB_XCNT(j)]); sum += c; cnt += (c > 0u) ? 1u : 0u; mine = (j == x) ? c : mine; }
        if (sum == G) break;
        __builtin_amdgcn_s_sleep(1);
        if ((++sp & 255u) == 0u) { if (xb_ld(&bar[XB_TMO])) break; if (sp > XB_SPIN_CAP) { atomicAdd(&bar[XB_TMO], 1u); break; } }
    }
    nloc = mine > 0u ? mine : 1u; nx = cnt > 0u ? cnt : 1u;
}

__device__ __forceinline__ void xcd_barrier(const XcdBarrier& b) {
    asm volatile("s_waitcnt vmcnt(0)" ::: "memory");
    __syncthreads();
    if (threadIdx.x == 0) {
        unsigned* bar = b.bar;
        __builtin_amdgcn_s_waitcnt(0);
        unsigned nloc = b.st[0], nx = b.st[1];
        if (nloc == 0u) { xcd_barrier_complete(bar, b.x, nloc, nx); b.st[0] = nloc; b.st[1] = nx; }
        const unsigned old = xb_add(&bar[XB_XSUB(b.x)], 1u);
        const unsigned gen = old / nloc;
        if (old + 1u == (gen + 1u) * nloc) {
            __builtin_amdgcn_fence(__ATOMIC_RELEASE, "agent");
            asm volatile("s_waitcnt vmcnt(0)" ::: "memory");
            const unsigned og = xb_add(&bar[XB_TOP], 1u);
            const unsigned tg = og / nx;
            if (og + 1u == (tg + 1u) * nx) xb_add(&bar[XB_TOPGEN], 1u);
            else XB_SPIN(xb_ld(&bar[XB_TOPGEN]) == tg, bar);
            __builtin_amdgcn_fence(__ATOMIC_ACQUIRE, "agent");
            xb_add(&bar[XB_XGEN(b.x)], 1u);
            asm volatile("s_waitcnt vmcnt(0)" ::: "memory");
        } else {
            XB_SPIN(xb_ld(&bar[XB_XGEN(b.x)]) == gen, bar);
            __builtin_amdgcn_fence(__ATOMIC_ACQUIRE, "agent");
            asm volatile("s_waitcnt vmcnt(0)" ::: "memory");
        }
    }
    __syncthreads();
}
constexpr size_t WS_BAR = 512 * 1024;
constexpr int MISC_OFF = LDS_BYTES - 64;
struct Args { const float* in[13]; float* out; unsigned char* ws; };
__global__ void __launch_bounds__(NT, 2) hybrid_fwd(Args args) {
    extern __shared__ __attribute__((aligned(16))) unsigned char lds_raw[];
    cg::grid_group grid = cg::this_grid();
    LAS unsigned char* lds = (LAS unsigned char*)lds_raw;
    const int tid0 = threadIdx.x, wid = __builtin_amdgcn_readfirstlane(tid0 >> 6);
    const int G = gridDim.x, bx = blockIdx.x;
    const int gw = bx * NWAVES + wid, NGW = G * NWAVES;
    unsigned char* ws = args.ws;
    const float* x_in = args.in[0];
    float* X = args.out;
    bf16* WinT = (bf16*)(ws + WS_WIN); bf16* WoutT = (bf16*)(ws + WS_WOUT); bf16* WupT = (bf16*)(ws + WS_WUP); bf16* WdnT = (bf16*)(ws + WS_WDN);
    bf16* XN = (bf16*)(ws + WS_XN); bf16* PROJ = (bf16*)(ws + WS_PROJ); bf16* MIX = (bf16*)(ws + WS_MIX); bf16* U = (bf16*)(ws + WS_U);
    volatile LAS unsigned* MISC = (volatile LAS unsigned*)(lds + MISC_OFF);
    if (tid0 < 16) MISC[tid0] = 0u;
    unsigned* barw = (unsigned*)(ws + WS_BAR);
    if (bx == 0) for (int u = tid0; u < XCD_BAR_WORDS; u += NT) barw[u] = 0u;
    __syncthreads();
    XcdBarrier xbar; xbar.bar = barw; xbar.x = 0; xbar.st = MISC;
    bf16* KVS = (bf16*)(ws + WS_KVS); float* DEC = (float*)(ws + WS_DEC); float* SSQ = (float*)ws;

#pragma unroll 1
    for (int l = 0; l < DEPTH; ++l) {
        int tid = tid0; asm volatile("" : "+v"(tid));
        const int lane = tid & 63;
        const float* n1g = args.in[1] + (size_t)l * DM;
        const float* w_in = args.in[2] + (size_t)l * DM * INW;
        const float* qng = args.in[3] + l * 64; const float* kng = args.in[4] + l * 64; const float* sinks = args.in[5] + l * 16;
        const float* ggw = args.in[6] + (size_t)l * 16 * 512; const float* ggb = args.in[7] + l * 512; const float* gng = args.in[8] + l * 256;
        const float* w_out = args.in[9] + (size_t)l * DM * DM; const float* n2g = args.in[10] + (size_t)l * DM;
        const float* w_up = args.in[11] + (size_t)l * DM * DFF; const float* w_dn = args.in[12] + (size_t)l * DFF * DM;
        const float* xsrc = (l == 0) ? x_in : X;
        const ConvCtx cx{w_out, w_up, w_dn, WoutT, WupT, WdnT};

        {
            LAS float* scr = (LAS float*)(lds + wid * 16512);
            constexpr int I_IN = (DM / 32) * (LDP / 128);
#pragma unroll 1
            for (int it = gw; it < I_IN; it += NGW) transpose_item(w_in, DM, INW, LDP, WinT, scr, it, lane);
            if (l == 0) {
#pragma unroll 1
                for (int m = gw; m < M; m += NGW) prep_row(x_in + (size_t)m * DM, n1g, XN + (size_t)m * DM, SSQ + m, lane);
#pragma unroll 1
                for (int e0 = bx * NT; e0 < 3 * M; e0 += G * NT) { const int e = e0 + tid; if (e < 3 * M) SSQ[M + e] = 0.f; }
            }
        }
        if (l == 0) { grid.sync(); xbar = xcd_barrier_post(barw, MISC); } else xcd_barrier(xbar);
#ifndef NO_P1
        { pg8::Gemm g{XN, WinT, M, LDP, DM}; pg8::StaticOrder S; S.init(M, LDP, G, bx); pg8::EpiBf16<0> E{PROJ, LDP, SSQ + (size_t)(2 * l) * M};
          pg8::gemm_phase<pg8::EpiBf16<0>, pg8::StaticOrder, true, true>(lds, g, S, E); }
#endif
        xcd_barrier(xbar);
#ifndef NO_ATTN
#pragma unroll 1
        for (int it = bx; it < 512; it += G) attn_item(lds, it, PROJ, MIX, qng, kng, sinks, cx, it, tid, lane, wid);
#endif
#ifndef NO_GLAL
        {
#pragma unroll 1
            for (int g = bx; g < 256; g += G) { float gwr[16]; const int hh = g & 3;
#pragma unroll
                for (int r = 0; r < 16; ++r) gwr[r] = ggw[r * 512 + hh * 128 + (tid & 127)];
                gla_local_group(lds, g, PROJ, KVS, DEC, gwr, ggb[hh * 128 + (tid & 127)], cx, 512 + g, tid, lane, wid); }
        }
#endif
        xcd_barrier(xbar);
#pragma unroll 1
        for (int e = bx * NT + tid; e < 131072; e += G * NT) {
            const int bh = e >> 14, rem = (e & 16383) * 2, dk = rem & 127;
            unsigned* p = (unsigned*)(KVS + (size_t)bh * 32 * 32768 + rem); const pg8::f32x2_t* d = (const pg8::f32x2_t*)(DEC + (size_t)bh * 32 * 128 + dk);
            float s0 = 0.f, s1 = 0.f; unsigned ub[2][16]; pg8::f32x2_t db[2][16];
#pragma unroll
            for (int nb = 0; nb < 2; ++nb)
#pragma unroll
                for (int i = 0; i < 16; ++i) { ub[nb][i] = p[(size_t)(nb * 16 + i) * 16384]; db[nb][i] = d[(nb * 16 + i) * 64]; }
#pragma unroll
            for (int nb = 0; nb < 2; ++nb)
#pragma unroll
                for (int i = 0; i < 16; ++i) { const unsigned u = ub[nb][i]; const pg8::f32x2_t dd = db[nb][i]; p[(size_t)(nb * 16 + i) * 16384] = pk(s0, s1); s0 = s0 * dd.x + bflo(u); s1 = s1 * dd.y + bfhi(u); }
        }
        xcd_barrier(xbar);
#ifndef NO_GLAO
#pragma unroll 1
        for (int g = bx; g < 256; g += G) gla_out_group(lds, g, PROJ, KVS, MIX, ggw, ggb, gng, cx, 1536 + g, tid, lane, wid);
#endif
        xcd_barrier(xbar);
#ifndef NO_P3
        { pg8::Gemm g{MIX, WoutT, M, DM, DM}; pg8::StaticOrder S; S.init(M, DM, G, bx); pg8::EpiRes<true> E{xsrc, X, DM, n2g, XN, SSQ + (size_t)(2 * l + 1) * M};
          pg8::gemm_phase<pg8::EpiRes<true>, pg8::StaticOrder, true, true>(lds, g, S, E); }
#endif
        xcd_barrier(xbar);
#ifndef NO_P4
        { pg8::Gemm g{XN, WupT, M, DFF, DM}; pg8::StaticOrder S; S.init(M, DFF, G, bx); pg8::EpiBf16<2> E{U, DFF, SSQ + (size_t)(2 * l + 1) * M};
          pg8::gemm_phase<pg8::EpiBf16<2>, pg8::StaticOrder, true, true>(lds, g, S, E); }
#endif
        xcd_barrier(xbar);
#ifndef NO_P5
        { pg8::Gemm g{U, WdnT, M, DM, DFF}; pg8::StaticOrder S; S.init(M, DM, G, bx);
          if (l + 1 < DEPTH) { pg8::EpiRes<true> E{X, X, DM, n1g + DM, XN, SSQ + (size_t)(2 * l + 2) * M}; pg8::gemm_phase<pg8::EpiRes<true>, pg8::StaticOrder, true, true>(lds, g, S, E); }
          else { pg8::EpiRes<false> E{X, X, DM, nullptr, nullptr, nullptr}; pg8::gemm_phase<pg8::EpiRes<false>, pg8::StaticOrder, true, true>(lds, g, S, E); } }
#endif
        if (l + 1 < DEPTH) xcd_barrier(xbar);
    }
}

extern "C" void kernel_launch(void* const* d_in, const int* in_sizes, int n_in, void* d_out, int out_size, void* d_ws, size_t ws_size, hipStream_t stream) {
    static int grid = 0;
    if (grid == 0) {
        if (n_in != 13 || out_size != M * DM || ws_size < WS_END) { fprintf(stderr, "kernel_launch: unexpected shapes (n_in %d out %d ws %zu)\n", n_in, out_size, ws_size); grid = -1; return; }
        int dev = 0, cus = 0, per_cu = 0;
        (void)hipGetDevice(&dev); (void)hipDeviceGetAttribute(&cus, hipDeviceAttributeMultiprocessorCount, dev);
        (void)hipFuncSetAttribute((const void*)hybrid_fwd, hipFuncAttributeMaxDynamicSharedMemorySize, LDS_BYTES);
        if (hipOccupancyMaxActiveBlocksPerMultiprocessor(&per_cu, (const void*)hybrid_fwd, NT, LDS_BYTES) != hipSuccess || per_cu < 1) per_cu = 1;
        (void)hipGetLastError();
        grid = cus * per_cu;
    }
    if (grid < 0) return;
    Args a{};
    for (int i = 0; i < 13; ++i) a.in[i] = (const float*)d_in[i];
    a.out = (float*)d_out; a.ws = (unsigned char*)d_ws;
    void* kargs[] = {&a};
    hipError_t e = hipLaunchCooperativeKernel((const void*)hybrid_fwd, dim3(grid), dim3(NT), kargs, LDS_BYTES, stream);
    if (e != hipSuccess) fprintf(stderr, "cooperative launch failed: %s (grid %d)\n", hipGetErrorString(e), grid);
}
```
